# Optimizing an MI355X kernel written in HIP

```python
import math
import jax
import jax.numpy as jnp
from jax import lax
import numpy as np

D_MODEL = 1024
BATCH = 32
SEQ = 2048
DEPTH = 4

GRID_W = 64
CTX_LEN = 256
N_MIXERS = 2
CHUNK_A = 128
D_A = 2 * D_MODEL
GROUPS_A = 8
RET_HEADS = 4
RET_DK = D_MODEL // RET_HEADS
RET_DV = 2 * RET_DK
RET_CHUNK = 128
QK_W = RET_HEADS * RET_DK
V_W = RET_HEADS * RET_DV
B_IN_W = 2 * QK_W + 3 * V_W
ROPE_BASE = 10000.0
D_FF = 4 * D_MODEL
LN_EPS = 1e-5
DN_ALPHA = (2 * DEPTH) ** 0.25
DN_BETA = (8 * DEPTH) ** -0.25
N_A_LAYERS = (DEPTH + 1) // 2
N_B_LAYERS = DEPTH // 2

kernel_name = 'hybrid_gmlp_retention_deepnorm_dit'


def _layernorm(x, g, b):
    x32 = x.astype(jnp.float32)
    mu = jnp.mean(x32, -1, keepdims=True)
    var = jnp.mean(jnp.square(x32 - mu), -1, keepdims=True)
    return ((x32 - mu) * lax.rsqrt(var + LN_EPS)).astype(x.dtype) * g + b


def _headnorm(y):
    mu = jnp.mean(y, -1, keepdims=True)
    var = jnp.mean(jnp.square(y - mu), -1, keepdims=True)
    return (y - mu) * lax.rsqrt(var + LN_EPS)


def _sq_relu_mlp(h, w1, w2):
    return jnp.square(jax.nn.relu(h @ w1)) @ w2


def _chunk_gmlp(h, w_in, b_in, ln_g, ln_b, w_s, b_s, w_out):
    bn, L, _ = h.shape
    z = jax.nn.gelu(h @ w_in + b_in, approximate=False)
    u, v = z[..., :D_A], z[..., D_A:]
    v = _layernorm(v, ln_g, ln_b)
    v = v.reshape(bn, L // CHUNK_A, CHUNK_A, GROUPS_A, D_A // GROUPS_A)
    s = jnp.einsum('gij,bnjgc->bnigc', w_s, v) + b_s.T[:, :, None]
    return (u * s.reshape(bn, L, D_A)) @ w_out


def _rope_2d_tables(L, dtype):
    t = jnp.arange(L)
    row = (t // GRID_W).astype(jnp.float32)
    col = (t % GRID_W).astype(jnp.float32)
    n_freq = RET_DK // 4
    inv = ROPE_BASE ** (-jnp.arange(n_freq, dtype=jnp.float32) / n_freq)
    ang = jnp.concatenate([row[:, None] * inv, col[:, None] * inv], -1)
    return jnp.cos(ang).astype(dtype), jnp.sin(ang).astype(dtype)


def _rope(t, cos, sin):
    half = t.shape[-1] // 2
    t1, t2 = t[..., :half], t[..., half:]
    cs, sn = cos[None, :, None, :], sin[None, :, None, :]
    return jnp.concatenate([t1 * cs - t2 * sn, t1 * sn + t2 * cs], -1)


def _retention_scan(q, k, v, log_gamma, s0):
    bn, L, H, _ = q.shape
    dv = v.shape[-1]
    C = RET_CHUNK
    n = L // C
    pos = jnp.arange(C, dtype=jnp.float32)
    diff = pos[:, None] - pos[None, :]
    decay_in = jnp.where(diff[None] >= 0, jnp.exp(log_gamma[:, None, None] * jnp.maximum(diff, 0.0)[None]), 0.0)
    xi = jnp.exp(log_gamma[None, :] * (pos[:, None] + 1.0))
    zeta = jnp.exp(log_gamma[None, :] * (C - 1.0 - pos[:, None]))
    gamma_c = jnp.exp(log_gamma * C)

    def to_chunks(t):
        return t.astype(jnp.float32).reshape(bn, n, C, H, t.shape[-1]).swapaxes(0, 1)

    def step(S, qkv):
        qc, kc, vc = qkv
        scores = jnp.einsum('bihd,bjhd->bhij', qc, kc) * decay_in[None]
        intra = jnp.einsum('bhij,bjhe->bihe', scores, vc)
        inter = jnp.einsum('bihd,bhde->bihe', qc, S) * xi[None, :, :, None]
        S = S * gamma_c[None, :, None, None] + jnp.einsum('bjhd,bjhe->bhde', kc * zeta[None, :, :, None], vc)
        return S, intra + inter

    S, out = lax.scan(step, s0, (to_chunks(q), to_chunks(k), to_chunks(v)))
    return out.swapaxes(0, 1).reshape(bn, L, H, dv), S


def _retention_out(o_f, o_b, g_f, g_b, w_out):
    y = _headnorm(o_f) * jax.nn.silu(g_f.astype(jnp.float32)) + _headnorm(o_b) * jax.nn.silu(g_b.astype(jnp.float32))
    bn, L = y.shape[:2]
    return y.reshape(bn, L, V_W).astype(w_out.dtype) @ w_out


def _split_heads(p, bn, L):
    q = p[..., :QK_W].reshape(bn, L, RET_HEADS, RET_DK)
    k = p[..., QK_W:2 * QK_W].reshape(bn, L, RET_HEADS, RET_DK) * (RET_DK ** -0.5)
    v = p[..., 2 * QK_W:2 * QK_W + V_W].reshape(bn, L, RET_HEADS, RET_DV)
    return q, k, v


def _gates(p, bn, L):
    o = 2 * QK_W + V_W
    g_f = p[..., o:o + V_W].reshape(bn, L, RET_HEADS, RET_DV)
    g_b = p[..., o + V_W:o + 2 * V_W].reshape(bn, L, RET_HEADS, RET_DV)
    return g_f, g_b


def _retention_mixer(h_l, h_c, w_in, decay_p, w_out, need_ctx_out):
    bn, L, _ = h_l.shape
    lc = h_c.shape[1]
    log_gamma = jnp.log1p(-jnp.exp(decay_p.astype(jnp.float32)))
    flip = lambda t: jnp.flip(t, 1)

    p_c = h_c @ (w_in if need_ctx_out else w_in[:, :2 * QK_W + V_W])
    q_c, k_c, v_c = _split_heads(p_c, bn, lc)
    s0 = jnp.zeros((bn, RET_HEADS, RET_DK, RET_DV), jnp.float32)
    of_c, s_f = _retention_scan(q_c, k_c, v_c, log_gamma[0], s0)
    ob_c, s_b = _retention_scan(flip(q_c), flip(k_c), flip(v_c), log_gamma[1], s0)

    p_l = h_l @ w_in
    q_l, k_l, v_l = _split_heads(p_l, bn, L)
    cos, sin = _rope_2d_tables(L, q_l.dtype)
    q_l, k_l = _rope(q_l, cos, sin), _rope(k_l, cos, sin)
    of_l, _ = _retention_scan(q_l, k_l, v_l, log_gamma[0], s_f)
    ob_l, _ = _retention_scan(flip(q_l), flip(k_l), flip(v_l), log_gamma[1], s_b)
    gf_l, gb_l = _gates(p_l, bn, L)
    y_l = _retention_out(of_l, flip(ob_l), gf_l, gb_l, w_out)
    if need_ctx_out:
        gf_c, gb_c = _gates(p_c, bn, lc)
        y_c = _retention_out(of_c, flip(ob_c), gf_c, gb_c, w_out)
    else:
        y_c = None
    return y_l, y_c


def setup_inputs(seed: int = 0) -> dict:
    key = jax.random.key(seed)
    ks = jax.random.split(key, 26)
    f32 = jnp.float32

    def nrm(k, shape, scale=1.0):
        return jax.random.normal(k, shape, f32) * scale

    h_idx = jnp.arange(RET_HEADS, dtype=f32)
    decay_base = -(5.0 + h_idx) * jnp.log(2.0)
    return {
        'x': nrm(ks[0], (BATCH, SEQ, D_MODEL)),
        'c': nrm(ks[1], (BATCH, D_MODEL)),
        'ctx': nrm(ks[2], (BATCH, CTX_LEN, D_MODEL)),
        'c_ctx': nrm(ks[3], (D_MODEL,)),
        'ada_w': nrm(ks[4], (DEPTH, D_MODEL, 6 * D_MODEL), D_MODEL ** -0.5),
        'ada_b': nrm(ks[5], (DEPTH, 6 * D_MODEL), 0.02),
        'ln1_g': 1.0 + nrm(ks[6], (DEPTH, D_MODEL), 0.02),
        'ln1_b': nrm(ks[7], (DEPTH, D_MODEL), 0.02),
        'ln2_g': 1.0 + nrm(ks[8], (DEPTH, D_MODEL), 0.02),
        'ln2_b': nrm(ks[9], (DEPTH, D_MODEL), 0.02),
        'ffn_w1': nrm(ks[10], (DEPTH, D_MODEL, D_FF), D_MODEL ** -0.5),
        'ffn_w2': nrm(ks[11], (DEPTH, D_FF, D_MODEL), D_FF ** -0.5 * DN_BETA),
        'a_w_in': nrm(ks[12], (N_A_LAYERS, D_MODEL, 2 * D_A), D_MODEL ** -0.5),
        'a_b_in': nrm(ks[13], (N_A_LAYERS, 2 * D_A), 0.02),
        'a_ln_g': 1.0 + nrm(ks[14], (N_A_LAYERS, D_A), 0.02),
        'a_ln_b': nrm(ks[15], (N_A_LAYERS, D_A), 0.02),
        'a_w_s': nrm(ks[16], (N_A_LAYERS, GROUPS_A, CHUNK_A, CHUNK_A), CHUNK_A ** -0.5),
        'a_b_s': 1.0 + nrm(ks[17], (N_A_LAYERS, GROUPS_A, CHUNK_A), 0.02),
        'a_w_out': nrm(ks[18], (N_A_LAYERS, D_A, D_MODEL), D_A ** -0.5 * DN_BETA),
        'b_w_in': nrm(ks[19], (N_B_LAYERS, D_MODEL, B_IN_W), D_MODEL ** -0.5),
        'b_decay': jnp.broadcast_to(decay_base, (N_B_LAYERS, 2, RET_HEADS)) + nrm(ks[20], (N_B_LAYERS, 2, RET_HEADS), 0.05),
        'b_w_out': nrm(ks[21], (N_B_LAYERS, V_W, D_MODEL), V_W ** -0.5 * DN_BETA),
    }


def reference(x, c, ctx, c_ctx, ada_w, ada_b, ln1_g, ln1_b, ln2_g, ln2_b, ffn_w1, ffn_w2,
              a_w_in, a_b_in, a_ln_g, a_ln_b, a_w_s, a_b_s, a_w_out, b_w_in, b_decay, b_w_out):
    sc = jax.nn.silu(c)
    scc = jax.nn.silu(c_ctx)
    for i in range(DEPTH):
        need_ctx_out = i < DEPTH - 1
        mod_l = sc @ ada_w[i] + ada_b[i]
        sh1, s1, g1, sh2, s2, g2 = jnp.split(mod_l[:, None, :], 6, axis=-1)
        mod_c = scc @ ada_w[i] + ada_b[i]
        sh1c, s1c, g1c, sh2c, s2c, g2c = jnp.split(mod_c, 6, axis=-1)
        j = i // N_MIXERS
        h_l = x * (1.0 + s1) + sh1
        if i % N_MIXERS == 0:
            y_l = _chunk_gmlp(h_l, a_w_in[j], a_b_in[j], a_ln_g[j], a_ln_b[j], a_w_s[j], a_b_s[j], a_w_out[j])
            if need_ctx_out:
                y_c = _chunk_gmlp(ctx * (1.0 + s1c) + sh1c, a_w_in[j], a_b_in[j], a_ln_g[j], a_ln_b[j],
                                  a_w_s[j], a_b_s[j], a_w_out[j])
        else:
            y_l, y_c = _retention_mixer(h_l, ctx * (1.0 + s1c) + sh1c, b_w_in[j], b_decay[j], b_w_out[j],
                                        need_ctx_out)
        x = _layernorm(DN_ALPHA * x + g1 * y_l, ln1_g[i], ln1_b[i])
        x = _layernorm(DN_ALPHA * x + g2 * _sq_relu_mlp(x * (1.0 + s2) + sh2, ffn_w1[i], ffn_w2[i]),
                       ln2_g[i], ln2_b[i])
        if need_ctx_out:
            ctx = _layernorm(DN_ALPHA * ctx + g1c * y_c, ln1_g[i], ln1_b[i])
            ctx = _layernorm(DN_ALPHA * ctx + g2c * _sq_relu_mlp(ctx * (1.0 + s2c) + sh2c, ffn_w1[i], ffn_w2[i]),
                             ln2_g[i], ln2_b[i])
    return x
```

```cpp
#include <hip/hip_runtime.h>
#include <hip/hip_cooperative_groups.h>
#include <cstdio>
#include <cstdint>
#include <cstddef>
namespace pg8 {
#define PG8_LAS __attribute__((address_space(3)))
typedef unsigned short bf16_t;
typedef short bf16x8 __attribute__((ext_vector_type(8)));
typedef float f32x4 __attribute__((ext_vector_type(4)));
typedef unsigned u32x4 __attribute__((ext_vector_type(4)));
constexpr int BM = 256, BK = 64, HALF = 128, HTB = HALF * BK * 2  , STAGE_BYTES = 8 * HTB, NXCD = 8, WGM = 8;

__host__ __device__ __forceinline__ int lds_byte(int r, int c) { const int st = (r >> 4) * 2 + (c >> 5), rr = r & 15, cc = c & 31, ob = rr * 64 + cc * 2; return st * 1024 + (ob ^ (((ob >> 9) & 1) << 5)); }
__host__ __device__ __forceinline__ void stage_rc(int b, int& R, int& C) { const int st = b / 1024, sb = b % 1024, swz = sb ^ (((sb >> 9) & 1) << 5); R = (st >> 1) * 16 + swz / 64; C = (st & 1) * 32 + (swz % 64) / 2; }
__host__ __device__ __forceinline__ int perm32(int rho) { const int n = rho >> 4, i = rho & 15; return 8 * (i >> 2) + 4 * n + (i & 3); }

struct Unit { int pm, pn; };
struct Gemm { const bf16_t* A; const bf16_t* Bt; int K, lda, ldb; };


__device__ __forceinline__ unsigned cvt_pk_bf16(float lo, float hi) { unsigned r; asm volatile("v_cvt_pk_bf16_f32 %0, %1, %2" : "=v"(r) : "v"(lo), "v"(hi)); return r; }
typedef float f32x2 __attribute__((ext_vector_type(2)));
__device__ __forceinline__ f32x2 gelu_pk(f32x2 v) {
    const f32x2 av = __builtin_elementwise_abs(v), d = av * 0.2316418882f + 1.0f;
    f32x2 t; t.x = __builtin_amdgcn_rcpf(d.x); t.y = __builtin_amdgcn_rcpf(d.y);
    f32x2 q = t * 0.5307027145f + (-0.7265760135f); q = q * t + 0.7107068705f; q = q * t + (-0.142248368f); q = q * t + 0.127414796f; q = q * t;
    const f32x2 s = (v * v) * (-0.72134752044f);
    f32x2 e; e.x = __builtin_amdgcn_exp2f(s.x); e.y = __builtin_amdgcn_exp2f(s.y);
    const f32x2 m = v * (q * e), r = v - m;
    f32x2 o; o.x = v.x < 0.f ? m.x : r.x; o.y = v.y < 0.f ? m.y : r.y; return o;
}


template <class Epi, class Sched, bool ALIGN_EPI = false, bool SP2 = false>
__device__ __forceinline__ void gemm_phase(PG8_LAS unsigned char* lds, const Gemm g, const Sched& S, const Epi& E) {
    int tid_ = threadIdx.x; asm volatile("" : "+v"(tid_));
    const int tid = tid_, wid = __builtin_amdgcn_readfirstlane(tid >> 6), lane = tid & 63, wr = wid >> 2, wc = wid & 3, fr = lane & 15, fq = lane >> 4;
    const int K = g.K, nt = K / BK;
    unsigned voffA[2], voffB[2];
#pragma unroll
    for (int i = 0; i < 2; ++i) { int R, C; stage_rc(tid * 16 + i * 8192, R, C); const int Rb = Epi::PERM ? ((R & ~31) + perm32(R & 31)) : R;
        voffA[i] = (unsigned)(R * g.lda + C) * 2u; voffB[i] = (unsigned)(Rb * g.ldb + C) * 2u; }
    const size_t kstep = (size_t)(BK * 2);
    const size_t hstepA = (size_t)HALF * g.lda * 2, hstepB = (size_t)HALF * g.ldb * 2;
    const size_t tstepA = 2 * hstepA, tstepB = 2 * hstepB;
    const unsigned ldsw = (unsigned)wid * 1024u;
    const int aoff = lds_byte(wr * 64 + fr, fq * 8), boff = lds_byte(wc * 32 + fr, fq * 8);
#define PG8_SA(b, h) (((b) * 2 + (h)) * HTB)
#define PG8_SB(b, h) ((4 + (b) * 2 + (h)) * HTB)
#define PG8_STAGE(bufoff, gbase, voff) do { _Pragma("unroll") for (int _i = 0; _i < 2; ++_i) \
        __builtin_amdgcn_global_load_lds((const unsigned*)((const char*)(gbase) + (voff)[_i]), (PG8_LAS unsigned*)(lds + (bufoff) + ldsw + _i * 8192), 16, 0, 0); } while (0)
#define PG8_LDA(dst, b, h) do { _Pragma("unroll") for (int m = 0; m < 4; ++m) _Pragma("unroll") for (int k = 0; k < 2; ++k) dst[m][k] = *(const PG8_LAS bf16x8*)(lds + PG8_SA(b, h) + aoff + m * 2048 + k * 1024); } while (0)
#define PG8_LDB(dst, b, h) do { _Pragma("unroll") for (int n = 0; n < 2; ++n) _Pragma("unroll") for (int k = 0; k < 2; ++k) dst[n][k] = *(const PG8_LAS bf16x8*)(lds + PG8_SB(b, h) + boff + n * 2048 + k * 1024); } while (0)
#define PG8_MMA(ai, bj, At, Bt) do { __builtin_amdgcn_s_setprio(1); _Pragma("unroll") for (int m = 0; m < 4; ++m) _Pragma("unroll") for (int n = 0; n < 2; ++n) _Pragma("unroll") for (int k = 0; k < 2; ++k) \
        acc[ai][bj][m][n] = __builtin_amdgcn_mfma_f32_16x16x32_bf16(Bt[n][k], At[m][k], acc[ai][bj][m][n], 0, 0, 0); __builtin_amdgcn_s_setprio(0); } while (0)
#define PG8_WAIT_V(n) asm volatile("s_waitcnt vmcnt(" #n ")" ::: "memory")
#define PG8_WAIT_L(n) asm volatile("s_waitcnt lgkmcnt(" #n ")" ::: "memory")
#define PG8_BAR __builtin_amdgcn_s_barrier()
#define PG8_SCHED __builtin_amdgcn_sched_barrier(0)
    Unit cur, nxt; int ui = 0;
    if (!S.next(0, cur)) return;
    f32x4 acc[2][2][4][2];
#pragma unroll
    for (int a = 0; a < 2; ++a)
#pragma unroll
        for (int b = 0; b < 2; ++b)
#pragma unroll
            for (int m = 0; m < 4; ++m)
#pragma unroll
                for (int n = 0; n < 2; ++n) acc[a][b][m][n] = (f32x4){0.f, 0.f, 0.f, 0.f};
    bf16x8 At[4][2], B0[2][2], B1[2][2];
    const char* cA = (const char*)g.A + (size_t)cur.pm * tstepA; const char* cB = (const char*)g.Bt + (size_t)cur.pn * tstepB;
    S.a_ready(cur);
    if constexpr (SP2) {
        PG8_STAGE(PG8_SB(0, 0), cB, voffB); PG8_STAGE(PG8_SB(0, 1), cB + hstepB, voffB); PG8_STAGE(PG8_SA(0, 0), cA, voffA); PG8_STAGE(PG8_SA(0, 1), cA + hstepA, voffA);
        if (wr == 1) PG8_BAR;
        PG8_WAIT_V(2); PG8_BAR;
        PG8_STAGE(PG8_SB(1, 0), cB + kstep, voffB); PG8_STAGE(PG8_SA(1, 0), cA + kstep, voffA); PG8_STAGE(PG8_SB(1, 1), cB + hstepB + kstep, voffB);
        PG8_WAIT_V(6); PG8_BAR;
    } else {
        PG8_STAGE(PG8_SB(0, 0), cB, voffB); PG8_STAGE(PG8_SA(0, 0), cA, voffA); PG8_STAGE(PG8_SB(0, 1), cB + hstepB, voffB); PG8_STAGE(PG8_SA(0, 1), cA + hstepA, voffA);
        if (wr == 1) PG8_BAR;
        PG8_WAIT_V(4); PG8_BAR;
        PG8_STAGE(PG8_SB(1, 0), cB + kstep, voffB); PG8_STAGE(PG8_SA(1, 0), cA + kstep, voffA); PG8_STAGE(PG8_SB(1, 1), cB + hstepB + kstep, voffB);
        PG8_WAIT_V(6); PG8_BAR;
    }
    for (;;) {
        const bool has_next = S.next(ui + 1, nxt);
        const char* nA = has_next ? (const char*)g.A + (size_t)nxt.pm * tstepA : cA; const char* nB = has_next ? (const char*)g.Bt + (size_t)nxt.pn * tstepB : cB;
        for (int t = 0; t < nt; t += 2) {
            const bool last = (t == nt - 2);
            const char* a1 = cA + (size_t)(t + 1) * kstep;
            const char* a2 = last ? nA : cA + (size_t)(t + 2) * kstep; const char* b2 = last ? nB : cB + (size_t)(t + 2) * kstep;
            const char* a3 = a2 + kstep; const char* b3 = b2 + kstep;
            if (last && has_next) S.a_ready(nxt);
            if constexpr (SP2) {
            PG8_LDB(B0, 0, 0); PG8_LDB(B1, 0, 1); PG8_SCHED; PG8_LDA(At, 0, 0); PG8_STAGE(PG8_SA(1, 1), a1 + hstepA, voffA);
            PG8_WAIT_V(8); PG8_WAIT_L(0); PG8_BAR; PG8_MMA(0, 0, At, B0); PG8_MMA(0, 1, At, B1); PG8_BAR; PG8_SCHED;
            PG8_LDA(At, 0, 1); PG8_STAGE(PG8_SB(0, 0), b2, voffB); PG8_STAGE(PG8_SB(0, 1), b2 + hstepB, voffB); PG8_STAGE(PG8_SA(0, 0), a2, voffA);
            PG8_WAIT_V(8); PG8_WAIT_L(0); PG8_BAR; PG8_MMA(1, 0, At, B0); PG8_MMA(1, 1, At, B1); PG8_BAR; PG8_SCHED;
            PG8_LDB(B0, 1, 0); PG8_LDB(B1, 1, 1); PG8_SCHED; PG8_LDA(At, 1, 0); PG8_STAGE(PG8_SA(0, 1), a2 + hstepA, voffA);
            PG8_WAIT_V(8); PG8_WAIT_L(0); PG8_BAR; PG8_MMA(0, 0, At, B0); PG8_MMA(0, 1, At, B1); PG8_BAR; PG8_SCHED;
            PG8_LDA(At, 1, 1); PG8_STAGE(PG8_SB(1, 0), b3, voffB); PG8_STAGE(PG8_SB(1, 1), b3 + hstepB, voffB); PG8_STAGE(PG8_SA(1, 0), a3, voffA);
            PG8_WAIT_V(8); PG8_WAIT_L(0); PG8_BAR; PG8_MMA(1, 0, At, B0); PG8_MMA(1, 1, At, B1); PG8_BAR; PG8_SCHED;
            } else {
            PG8_LDB(B0, 0, 0); PG8_SCHED; PG8_LDA(At, 0, 0); PG8_STAGE(PG8_SA(1, 1), a1 + hstepA, voffA);
            PG8_WAIT_L(8); PG8_BAR; PG8_WAIT_L(0); PG8_MMA(0, 0, At, B0); PG8_BAR; PG8_SCHED;
            PG8_LDB(B1, 0, 1); PG8_STAGE(PG8_SB(0, 0), b2, voffB);
            PG8_BAR; PG8_WAIT_L(0); PG8_MMA(0, 1, At, B1); PG8_BAR;
            PG8_LDA(At, 0, 1); PG8_STAGE(PG8_SA(0, 0), a2, voffA);
            PG8_BAR; PG8_WAIT_L(0); PG8_MMA(1, 0, At, B0); PG8_BAR; PG8_SCHED;
            PG8_STAGE(PG8_SB(0, 1), b2 + hstepB, voffB);
            PG8_WAIT_V(6); PG8_BAR; PG8_MMA(1, 1, At, B1); PG8_BAR;
            PG8_LDB(B0, 1, 0); PG8_SCHED; PG8_LDA(At, 1, 0); PG8_STAGE(PG8_SA(0, 1), a2 + hstepA, voffA);
            PG8_WAIT_L(8); PG8_BAR; PG8_WAIT_L(0); PG8_MMA(0, 0, At, B0); PG8_BAR; PG8_SCHED;
            PG8_LDB(B1, 1, 1); PG8_STAGE(PG8_SB(1, 0), b3, voffB);
            PG8_BAR; PG8_WAIT_L(0); PG8_MMA(0, 1, At, B1); PG8_BAR;
            PG8_LDA(At, 1, 1); PG8_STAGE(PG8_SA(1, 0), a3, voffA);
            PG8_BAR; PG8_WAIT_L(0); PG8_MMA(1, 0, At, B0); PG8_BAR; PG8_SCHED;
            PG8_STAGE(PG8_SB(1, 1), b3 + hstepB, voffB);
            PG8_WAIT_V(6); PG8_BAR; PG8_MMA(1, 1, At, B1); PG8_BAR;
            }
        }
        if constexpr (ALIGN_EPI) { if (wr == 0) PG8_BAR; }
        if constexpr (!Epi::AFTER_DRAIN) { E(acc, cur, wr, wc, fr, fq); S.done(cur); }
        if (!has_next) break;
#pragma unroll
        for (int a = 0; a < 2; ++a)
#pragma unroll
            for (int b = 0; b < 2; ++b)
#pragma unroll
                for (int m = 0; m < 4; ++m)
#pragma unroll
                    for (int n = 0; n < 2; ++n) acc[a][b][m][n] = (f32x4){0.f, 0.f, 0.f, 0.f};
        cur = nxt; cA = nA; cB = nB; ++ui;
        if constexpr (ALIGN_EPI) { if (wr == 1) PG8_BAR; }
    }
    PG8_WAIT_V(0);
    if constexpr (!ALIGN_EPI) { if (wr == 0) PG8_BAR; }
    PG8_BAR;
    if constexpr (Epi::AFTER_DRAIN) { E.fused(acc, cur, wr, wc, fr, fq, lds, wid, lane); S.done(cur); }
#undef PG8_SA
#undef PG8_SB
#undef PG8_STAGE
#undef PG8_LDA
#undef PG8_LDB
#undef PG8_MMA
#undef PG8_WAIT_V
#undef PG8_WAIT_L
#undef PG8_BAR
#undef PG8_SCHED
}
}

namespace cg = cooperative_groups;
using pg8::bf16_t; using pg8::bf16x8; using pg8::f32x4; using pg8::u32x4; using pg8::f32x2; using pg8::Unit; using pg8::cvt_pk_bf16;
#define LAS __attribute__((address_space(3)))
typedef short s16x4 __attribute__((ext_vector_type(4)));
typedef unsigned u32x2 __attribute__((ext_vector_type(2)));

constexpr int DM = 1024, NB = 32, RPB = 2304, MT = NB * RPB;
constexpr int HROWS = MT / 2;
constexpr int NTHR = 512, LDS_BYTES = 147456;
constexpr float LN_EPS = 1e-5f;
constexpr float DN_ALPHA = 1.6817928305074290f;

constexpr size_t SZ_W4 = (size_t)4096 * 1024 * 2;
constexpr size_t WS_MOD = 4096;
constexpr size_t WS_ROPE = WS_MOD + (size_t)4 * 33 * 6144 * 4;
constexpr size_t WS_CX = WS_ROPE + (size_t)2 * 2048 * 128 * 4;
constexpr size_t WS_WA_IN = WS_CX + (size_t)32 * 256 * 1024 * 4;
constexpr size_t WS_WA_OUT = WS_WA_IN + 2 * SZ_W4;
constexpr size_t WS_WB_QKV = WS_WA_OUT + SZ_W4;
constexpr size_t WS_WB_GATE = WS_WB_QKV + 2 * SZ_W4;
constexpr size_t WS_WB_OUT = WS_WB_GATE + 2 * SZ_W4;
constexpr size_t WS_W1 = WS_WB_OUT + SZ_W4;
constexpr size_t WS_W2 = WS_W1 + 4 * SZ_W4;
constexpr size_t WS_WS = WS_W2 + 4 * SZ_W4;
constexpr size_t WS_H = WS_WS + (size_t)2 * 8 * 128 * 128 * 2;
constexpr size_t WS_Z = WS_H + (size_t)MT * 1024 * 2;
constexpr size_t WS_ST = WS_Z + (size_t)MT * 4096 * 2;
constexpr size_t WS_END = WS_ST + (size_t)HROWS * 128 * 4;

struct Params {
    const float *x, *c, *ctx, *c_ctx, *ada_w, *ada_b, *ln1_g, *ln1_b, *ln2_g, *ln2_b, *ffn_w1, *ffn_w2, *a_w_in, *a_b_in, *a_ln_g, *a_ln_b, *a_w_s, *a_b_s, *a_w_out, *b_w_in, *b_decay, *b_w_out;
    float* out; unsigned char* ws;
};
typedef const unsigned long long __attribute__((address_space(4)))* KP64;
__device__ __forceinline__ Params kparams() {
    Params r;
#if defined(__HIP_DEVICE_COMPILE__)
    KP64 kp = (KP64)__builtin_amdgcn_kernarg_segment_ptr(); asm volatile("" : "+s"(kp));
    unsigned long long* d = (unsigned long long*)&r;
#pragma unroll
    for (int i = 0; i < (int)(sizeof(Params) / 8); ++i) d[i] = kp[i];
#endif
    return r;
}

__device__ __forceinline__ float bflo(unsigned w) { return __uint_as_float(w << 16); }
__device__ __forceinline__ float bfhi(unsigned w) { return __uint_as_float(w & 0xffff0000u); }
__device__ __forceinline__ float silu_f(float x) { return x / (1.f + __expf(-x)); }
__device__ __forceinline__ float wave_sum(float v) {
#pragma unroll
    for (int o = 32; o >= 1; o >>= 1) v += __shfl_xor(v, o);
    return v;
}
__device__ __forceinline__ f32x4 mfma16(bf16x8 a, bf16x8 b, f32x4 c) { return __builtin_amdgcn_mfma_f32_16x16x32_bf16(a, b, c, 0, 0, 0); }
__device__ __forceinline__ bf16x8 frag_tr(const LAS unsigned char* T, int ld, int k0, int x0, int lane) {
    const int fq = lane >> 4, li = lane & 15, q = li >> 2, p = li & 3;
    const LAS unsigned char* a = T + (k0 + 8 * fq + q) * ld + (x0 + 4 * p) * 2;
    const s16x4 lo = __builtin_amdgcn_ds_read_tr16_b64_v4i16((LAS s16x4*)a);
    const s16x4 hi = __builtin_amdgcn_ds_read_tr16_b64_v4i16((LAS s16x4*)(a + 4 * ld));
    bf16x8 r; r[0] = lo[0]; r[1] = lo[1]; r[2] = lo[2]; r[3] = lo[3]; r[4] = hi[0]; r[5] = hi[1]; r[6] = hi[2]; r[7] = hi[3];
    return r;
}
__device__ __forceinline__ bf16x8 frag_row(const LAS unsigned char* T, int ld, int x0, int k0, int lane) {
    return *(const LAS bf16x8*)(T + (x0 + (lane & 15)) * ld + (k0 + 8 * (lane >> 4)) * 2);
}
__device__ __forceinline__ u32x2 pack4(f32x4 v) { u32x2 w; w.x = cvt_pk_bf16(v[0], v[1]); w.y = cvt_pk_bf16(v[2], v[3]); return w; }

struct Sched {
    int nM, nN, nwg, G, c, pm_off, skip;
    __device__ void init(int nM_, int nN_, int G_, int c_, int pm_off_, int skip_) { nM = nM_; nN = nN_; nwg = nM * nN; G = G_; c = c_; pm_off = pm_off_; skip = skip_; }
    __device__ bool next(int i, Unit& u) const {
        const long L = (long)i * G + c; if (L >= nwg) return false;
        int wgid = (int)L; { const int q = nwg / pg8::NXCD, r = nwg % pg8::NXCD, xcd = wgid % pg8::NXCD, off = wgid / pg8::NXCD; wgid = (xcd < r ? xcd * (q + 1) : r * (q + 1) + (xcd - r) * q) + off; }
        const int nig = pg8::WGM * nN, gid = wgid / nig, fm = gid * pg8::WGM, gsz = (nM - fm) < pg8::WGM ? (nM - fm) : pg8::WGM;
        int pm = fm + ((wgid % nig) % gsz); u.pn = (wgid % nig) / gsz;
        if (skip) pm = (pm >> 3) * 9 + 1 + (pm & 7);
        u.pm = pm + pm_off; return true;
    }
    __device__ __forceinline__ void a_ready(const Unit&) const {}
    __device__ __forceinline__ void done(const Unit&) const {}
};

template <int ACT> struct EpiAct {
    static constexpr bool PERM = true, AFTER_DRAIN = false;
    bf16_t* O; int ldc; const float* bias;
    __device__ __forceinline__ void operator()(const f32x4 (&acc)[2][2][4][2], const Unit& u, int wr, int wc, int fr, int fq) const {
        const int row0 = u.pm * 256 + wr * 64 + fr, col0 = u.pn * 256 + wc * 32 + 8 * fq;
        f32x4 bv[2][2];
#pragma unroll
        for (int bj = 0; bj < 2; ++bj)
#pragma unroll
            for (int n = 0; n < 2; ++n) bv[bj][n] = (ACT == 1) ? *(const f32x4*)(bias + col0 + bj * 128 + 4 * n) : (f32x4){0.f, 0.f, 0.f, 0.f};
#pragma unroll
        for (int ai = 0; ai < 2; ++ai)
#pragma unroll
            for (int m = 0; m < 4; ++m) { bf16_t* rowp = O + (size_t)(row0 + ai * 128 + m * 16) * ldc + col0;
#pragma unroll
                for (int bj = 0; bj < 2; ++bj) { f32x4 v0 = acc[ai][bj][m][0], v1 = acc[ai][bj][m][1];
                    if (ACT == 1) { v0 = v0 + bv[bj][0]; v1 = v1 + bv[bj][1];
                        f32x2 a = pg8::gelu_pk((f32x2){v0[0], v0[1]}), b = pg8::gelu_pk((f32x2){v0[2], v0[3]}), c = pg8::gelu_pk((f32x2){v1[0], v1[1]}), d = pg8::gelu_pk((f32x2){v1[2], v1[3]});
                        v0 = (f32x4){a.x, a.y, b.x, b.y}; v1 = (f32x4){c.x, c.y, d.x, d.y}; }
                    if (ACT == 2) {
#pragma unroll
                        for (int j = 0; j < 4; ++j) { const float p0 = fmaxf(v0[j], 0.f), p1 = fmaxf(v1[j], 0.f); v0[j] = p0 * p0; v1[j] = p1 * p1; } }
                    u32x4 w; w.x = cvt_pk_bf16(v0[0], v0[1]); w.y = cvt_pk_bf16(v0[2], v0[3]); w.z = cvt_pk_bf16(v1[0], v1[1]); w.w = cvt_pk_bf16(v1[2], v1[3]);
                    *(u32x4*)(rowp + bj * 128) = w; } }
    }
};
struct EpiQKV {
    static constexpr bool PERM = true, AFTER_DRAIN = false;
    bf16_t* O; const float* rc; const float* rs;
    __device__ __forceinline__ void operator()(const f32x4 (&acc)[2][2][4][2], const Unit& u, int wr, int wc, int fr, int fq) const {
        const int pb = u.pm % 9, kind = u.pn >> 2;
        const bool rope = (pb != 0) && (kind < 2);
        const float sc = (kind == 1) ? 0.0625f : 1.f;
        const int row0 = u.pm * 256 + wr * 64 + fr, col0 = u.pn * 256 + wc * 32 + 8 * fq, i0 = wc * 32 + 8 * fq;
#pragma unroll
        for (int ai = 0; ai < 2; ++ai)
#pragma unroll
            for (int m = 0; m < 4; ++m) {
                bf16_t* rowp = O + (ptrdiff_t)(row0 + ai * 128 + m * 16) * 4096 + col0;
                f32x4 a0 = acc[ai][0][m][0] * sc, a1 = acc[ai][0][m][1] * sc, b0 = acc[ai][1][m][0] * sc, b1 = acc[ai][1][m][1] * sc;
                if (rope) {
                    const int t = (pb - 1) * 256 + ai * 128 + wr * 64 + m * 16 + fr;
                    const f32x4 c0 = *(const f32x4*)(rc + t * 128 + i0), c1 = *(const f32x4*)(rc + t * 128 + i0 + 4);
                    const f32x4 s0 = *(const f32x4*)(rs + t * 128 + i0), s1 = *(const f32x4*)(rs + t * 128 + i0 + 4);
                    const f32x4 o0 = a0 * c0 - b0 * s0, o1 = a1 * c1 - b1 * s1, p0 = a0 * s0 + b0 * c0, p1 = a1 * s1 + b1 * c1;
                    a0 = o0; a1 = o1; b0 = p0; b1 = p1;
                }
                u32x4 w; w.x = cvt_pk_bf16(a0[0], a0[1]); w.y = cvt_pk_bf16(a0[2], a0[3]); w.z = cvt_pk_bf16(a1[0], a1[1]); w.w = cvt_pk_bf16(a1[2], a1[3]);
                *(u32x4*)rowp = w;
                w.x = cvt_pk_bf16(b0[0], b0[1]); w.y = cvt_pk_bf16(b0[2], b0[3]); w.z = cvt_pk_bf16(b1[0], b1[1]); w.w = cvt_pk_bf16(b1[2], b1[3]);
                *(u32x4*)(rowp + 128) = w;
            }
    }
};
struct EpiGate {
    static constexpr bool PERM = true, AFTER_DRAIN = false;
    bf16_t* O; const float* ST;
    __device__ __forceinline__ void operator()(const f32x4 (&acc)[2][2][4][2], const Unit& u, int wr, int wc, int fr, int fq) const {
        const int row0 = u.pm * 256 + wr * 64 + fr, ch0 = u.pn * 128 + wc * 32 + 8 * fq, h = ch0 >> 9;
#pragma unroll
        for (int ai = 0; ai < 2; ++ai)
#pragma unroll
            for (int m = 0; m < 4; ++m) {
                const ptrdiff_t row = row0 + ai * 128 + m * 16;
                const float* sp = ST + (row * 4 + h) * 32;
                float mean[2], rstd[2];
#pragma unroll
                for (int d = 0; d < 2; ++d) {
                    const f32x4 p0 = *(const f32x4*)(sp + d * 16), p1 = *(const f32x4*)(sp + d * 16 + 4), p2 = *(const f32x4*)(sp + d * 16 + 8), p3 = *(const f32x4*)(sp + d * 16 + 12);
                    const float s = (p0[0] + p0[2]) + (p1[0] + p1[2]) + (p2[0] + p2[2]) + (p3[0] + p3[2]);
                    const float q = (p0[1] + p0[3]) + (p1[1] + p1[3]) + (p2[1] + p2[3]) + (p3[1] + p3[3]);
                    const float mu = s * (1.f / 512.f); const float var = fmaxf(q * (1.f / 512.f) - mu * mu, 0.f);
                    mean[d] = mu; rstd[d] = 1.0f / sqrtf(var + LN_EPS);
                }
                bf16_t* op = O + row * 4096 + ch0;
                const u32x4 of = *(const u32x4*)op, ob = *(const u32x4*)(op + 2048);
                float y[8];
#pragma unroll
                for (int e = 0; e < 8; ++e) {
                    const unsigned wf = of[e >> 1], wb = ob[e >> 1];
                    const float vf = (e & 1) ? bfhi(wf) : bflo(wf), vb = (e & 1) ? bfhi(wb) : bflo(wb);
                    const float gf = acc[ai][0][m][e >> 2][e & 3], gb = acc[ai][1][m][e >> 2][e & 3];
                    y[e] = (vf - mean[0]) * rstd[0] * silu_f(gf) + (vb - mean[1]) * rstd[1] * silu_f(gb);
                }
                u32x4 w; w.x = cvt_pk_bf16(y[0], y[1]); w.y = cvt_pk_bf16(y[2], y[3]); w.z = cvt_pk_bf16(y[4], y[5]); w.w = cvt_pk_bf16(y[6], y[7]);
                *(u32x4*)op = w;
            }
    }
};

template <class Epi> __device__ __forceinline__ void run_gemm(LAS unsigned char* lds, const bf16_t* A, int lda, const bf16_t* Bt, int K, int nM, int nN, int pm_off, int skip, const Epi& E) {
    pg8::Gemm g{A, Bt, K, lda, K}; Sched S; S.init(nM, nN, (int)gridDim.x, (int)blockIdx.x, pm_off, skip);
    pg8::gemm_phase<Epi, Sched, true, true>(lds, g, S, E);
}

__device__ __forceinline__ void conv_tile(LAS unsigned char* lds, const float* src, int ld, int col0, int k0, int n0, bf16_t* dst, int Kdst, bool gate, int tid) {
    LAS bf16_t* T = (LAS bf16_t*)lds;
#pragma unroll
    for (int it = 0; it < 2; ++it) {
        const int kk = (tid >> 4) + 32 * it, n4 = (tid & 15) * 4;
        const f32x4 v = *(const f32x4*)(src + (size_t)(k0 + kk) * ld + col0 + n0 + n4);
        const unsigned p01 = cvt_pk_bf16(v[0], v[1]), p23 = cvt_pk_bf16(v[2], v[3]);
        T[(n4 + 0) * 72 + kk] = (bf16_t)(p01 & 0xffffu); T[(n4 + 1) * 72 + kk] = (bf16_t)(p01 >> 16);
        T[(n4 + 2) * 72 + kk] = (bf16_t)(p23 & 0xffffu); T[(n4 + 3) * 72 + kk] = (bf16_t)(p23 >> 16);
    }
    __syncthreads();
    {
        const int n = tid >> 3, kc = (tid & 7) * 8;
        const u32x4 val = *(const LAS u32x4*)(T + n * 72 + kc);
        int nn = n0 + n;
        if (gate) { const int dir = nn >> 11, ch = nn & 2047; nn = (ch >> 7) * 256 + dir * 128 + (ch & 127); }
        *(u32x4*)(dst + (size_t)nn * Kdst + k0 + kc) = val;
    }
    __syncthreads();
}

__device__ __forceinline__ void prologue0(LAS unsigned char* lds) {
    const Params p = kparams();
    int tid = threadIdx.x; asm volatile("" : "+v"(tid));
    unsigned char* ws = p.ws;
    constexpr int N_MOD = 48, N_CONV = 16384, N_WS = 64, N_ROPE = 64, N_ITEMS = N_MOD + N_CONV + N_WS + N_ROPE;
    for (int it = blockIdx.x; it < N_ITEMS; it += gridDim.x) {
        if (it < N_MOD) {
            const int l = it / 12, n = (it - l * 12) * 512 + tid;
            LAS float* sct = (LAS float*)lds;
            float acc[36];
            const float b0 = p.ada_b[l * 6144 + n];
#pragma unroll
            for (int r = 0; r < 36; ++r) acc[r] = b0;
            for (int kh = 0; kh < 2; ++kh) {
                __syncthreads();
                for (int idx = tid; idx < 36 * 512; idx += NTHR) {
                    const int r = idx >> 9, kk = idx & 511;
                    float v = 0.f;
                    if (r < 32) v = silu_f(p.c[r * 1024 + kh * 512 + kk]); else if (r == 32) v = silu_f(p.c_ctx[kh * 512 + kk]);
                    sct[kk * 36 + r] = v;
                }
                __syncthreads();
                const float* wp = p.ada_w + ((size_t)l * 1024 + kh * 512) * 6144 + n;
#pragma unroll 4
                for (int kk = 0; kk < 512; ++kk) {
                    const float w = wp[(size_t)kk * 6144];
#pragma unroll
                    for (int r4 = 0; r4 < 9; ++r4) {
                        const f32x4 s = *(const LAS f32x4*)(sct + kk * 36 + r4 * 4);
                        acc[r4 * 4 + 0] += s[0] * w; acc[r4 * 4 + 1] += s[1] * w; acc[r4 * 4 + 2] += s[2] * w; acc[r4 * 4 + 3] += s[3] * w;
                    }
                }
            }
            float* mod = (float*)(ws + WS_MOD);
#pragma unroll
            for (int r = 0; r < 33; ++r) mod[((size_t)l * 33 + r) * 6144 + n] = acc[r];
            __syncthreads();
        } else if (it < N_MOD + N_CONV) {
            const int T = it - N_MOD;
            const float* src; int ld, col0 = 0, kt, nt, Kdst; bf16_t* dst; bool gate = false;
            if (T < 2048) { const int j = T >> 10, t = T & 1023; kt = t >> 6; nt = t & 63; src = p.a_w_in + (size_t)j * 1024 * 4096; ld = 4096; dst = (bf16_t*)(ws + WS_WA_IN + j * SZ_W4); Kdst = 1024; }
            else if (T < 3072) { const int T2 = T - 2048, j = T2 >> 9, t = T2 & 511; kt = t >> 4; nt = t & 15; src = p.a_w_out + (size_t)j * 2048 * 1024; ld = 1024; dst = (bf16_t*)(ws + WS_WA_OUT + j * (SZ_W4 / 2)); Kdst = 2048; }
            else if (T < 5120) { const int T2 = T - 3072, j = T2 >> 10, t = T2 & 1023; kt = t >> 6; nt = t & 63; src = p.b_w_in + (size_t)j * 1024 * 8192; ld = 8192; dst = (bf16_t*)(ws + WS_WB_QKV + j * SZ_W4); Kdst = 1024; }
            else if (T < 7168) { const int T2 = T - 5120, j = T2 >> 10, t = T2 & 1023; kt = t >> 6; nt = t & 63; src = p.b_w_in + (size_t)j * 1024 * 8192; ld = 8192; col0 = 4096; dst = (bf16_t*)(ws + WS_WB_GATE + j * SZ_W4); Kdst = 1024; gate = true; }
            else if (T < 8192) { const int T2 = T - 7168, j = T2 >> 9, t = T2 & 511; kt = t >> 4; nt = t & 15; src = p.b_w_out + (size_t)j * 2048 * 1024; ld = 1024; dst = (bf16_t*)(ws + WS_WB_OUT + j * (SZ_W4 / 2)); Kdst = 2048; }
            else if (T < 12288) { const int T2 = T - 8192, l = T2 >> 10, t = T2 & 1023; kt = t >> 6; nt = t & 63; src = p.ffn_w1 + (size_t)l * 1024 * 4096; ld = 4096; dst = (bf16_t*)(ws + WS_W1 + l * SZ_W4); Kdst = 1024; }
            else { const int T2 = T - 12288, l = T2 >> 10, t = T2 & 1023; kt = t >> 4; nt = t & 15; src = p.ffn_w2 + (size_t)l * 4096 * 1024; ld = 1024; dst = (bf16_t*)(ws + WS_W2 + l * SZ_W4); Kdst = 4096; }
            conv_tile(lds, src, ld, col0, kt * 64, nt * 64, dst, Kdst, gate, tid);
        } else if (it < N_MOD + N_CONV + N_WS) {
            const int base = (it - N_MOD - N_CONV) * 4096 + tid * 8;
            const f32x4 v0 = *(const f32x4*)(p.a_w_s + base), v1 = *(const f32x4*)(p.a_w_s + base + 4);
            u32x4 w; w.x = cvt_pk_bf16(v0[0], v0[1]); w.y = cvt_pk_bf16(v0[2], v0[3]); w.z = cvt_pk_bf16(v1[0], v1[1]); w.w = cvt_pk_bf16(v1[2], v1[3]);
            *(u32x4*)((bf16_t*)(ws + WS_WS) + base) = w;
        } else {
            float* rc = (float*)(ws + WS_ROPE); float* rs = rc + 2048 * 128;
            const int base = (it - N_MOD - N_CONV - N_WS) * 4096 + tid * 8;
#pragma unroll
            for (int e = 0; e < 8; ++e) {
                const int id = base + e, t = id >> 7, i = id & 127, f = i & 63;
                const float pos = (float)((i < 64) ? (t >> 6) : (t & 63));
                const float inv = __builtin_amdgcn_exp2f(-(float)f * (13.287712379549449f / 64.f));
                const float ang = pos * inv;
                float rev = ang * 0.15915494309189535f; rev -= rintf(rev);
                rc[id] = __builtin_amdgcn_cosf(rev); rs[id] = __builtin_amdgcn_sinf(rev);
            }
        }
    }
}

__device__ __forceinline__ void prologue1() {
    const Params p = kparams();
    int tid = threadIdx.x; asm volatile("" : "+v"(tid));
    const int lane = tid & 63, wid = tid >> 6;
    const float* mod = (const float*)(p.ws + WS_MOD);
    bf16_t* H = (bf16_t*)(p.ws + WS_H);
    for (int r = blockIdx.x * 8 + wid; r < MT; r += gridDim.x * 8) {
        const int b = r / RPB, j = r - b * RPB; const bool isctx = j < 256;
        const float* xs = isctx ? p.ctx + ((size_t)b * 256 + j) * 1024 : p.x + ((size_t)b * 2048 + (j - 256)) * 1024;
        const float* mr = mod + (size_t)(isctx ? 32 : b) * 6144;
#pragma unroll
        for (int q = 0; q < 4; ++q) {
            const int col = q * 256 + lane * 4;
            const f32x4 xv = *(const f32x4*)(xs + col), sh = *(const f32x4*)(mr + col), sc = *(const f32x4*)(mr + 1024 + col);
            const f32x4 h = xv * (sc + 1.0f) + sh;
            *(u32x2*)(H + (size_t)r * 1024 + col) = pack4(h);
        }
    }
}

__device__ __forceinline__ void ln_phase(int l, int which, bool last) {
    const Params p = kparams();
    const float* xl_src = (l == 0 && which == 0) ? p.x : p.out; const float* xc_src = (l == 0 && which == 0) ? p.ctx : (const float*)(p.ws + WS_CX);
    const int gate_off = which ? 5120 : 2048; const float* lng = (which ? p.ln2_g : p.ln1_g) + l * 1024; const float* lnb = (which ? p.ln2_b : p.ln1_b) + l * 1024;
    const int l_next = which ? (last ? l : l + 1) : l, sh_off = which ? 0 : 3072, sc_off = which ? 1024 : 4096; const bool write_h = which ? !last : true, skipctx = last;
    int tid = threadIdx.x; asm volatile("" : "+v"(tid));
    const int lane = tid & 63, wid = tid >> 6;
    const float* mod = (const float*)(p.ws + WS_MOD);
    bf16_t* H = (bf16_t*)(p.ws + WS_H);
    float* CX = (float*)(p.ws + WS_CX);
    for (int r = blockIdx.x * 8 + wid; r < MT; r += gridDim.x * 8) {
        const int b = r / RPB, j = r - b * RPB; const bool isctx = j < 256;
        if (isctx && skipctx) continue;
        const size_t xo = isctx ? ((size_t)b * 256 + j) * 1024 : ((size_t)b * 2048 + (j - 256)) * 1024;
        const float* xs = (isctx ? xc_src : xl_src) + xo;
        float* xd = (isctx ? CX : p.out) + xo;
        const int mrow = isctx ? 32 : b;
        const float* gate = mod + ((size_t)l * 33 + mrow) * 6144 + gate_off;
        f32x4 t[4]; float s = 0.f;
#pragma unroll
        for (int q = 0; q < 4; ++q) {
            const int col = q * 256 + lane * 4;
            const f32x4 xv = *(const f32x4*)(xs + col), gv = *(const f32x4*)(gate + col);
            const u32x2 yw = *(const u32x2*)(H + (size_t)r * 1024 + col);
            const f32x4 yv = {bflo(yw.x), bfhi(yw.x), bflo(yw.y), bfhi(yw.y)};
            t[q] = xv * DN_ALPHA + gv * yv;
            s += (t[q][0] + t[q][1]) + (t[q][2] + t[q][3]);
        }
        const float mean = wave_sum(s) * (1.f / 1024.f);
        float v = 0.f;
#pragma unroll
        for (int q = 0; q < 4; ++q) { const f32x4 d = t[q] - mean; v += (d[0] * d[0] + d[1] * d[1]) + (d[2] * d[2] + d[3] * d[3]); }
        const float rstd = 1.0f / sqrtf(wave_sum(v) * (1.f / 1024.f) + LN_EPS);
        const float* shp = mod + ((size_t)l_next * 33 + mrow) * 6144 + sh_off;
        const float* scp = mod + ((size_t)l_next * 33 + mrow) * 6144 + sc_off;
#pragma unroll
        for (int q = 0; q < 4; ++q) {
            const int col = q * 256 + lane * 4;
            const f32x4 g4 = *(const f32x4*)(lng + col), b4 = *(const f32x4*)(lnb + col);
            const f32x4 xn = (t[q] - mean) * rstd * g4 + b4;
            *(f32x4*)(xd + col) = xn;
            if (write_h) {
                const f32x4 sh = *(const f32x4*)(shp + col), sc = *(const f32x4*)(scp + col);
                *(u32x2*)(H + (size_t)r * 1024 + col) = pack4(xn * (sc + 1.0f) + sh);
            }
        }
    }
}

__device__ __forceinline__ void gating_phase(LAS unsigned char* lds, int jl) {
    const Params p = kparams();
    int tid_ = threadIdx.x; asm volatile("" : "+v"(tid_));
    const int tid = tid_, lane = tid & 63, wid = tid >> 6, fr = lane & 15, fq = lane >> 4;
    bf16_t* Z = (bf16_t*)(p.ws + WS_Z);
    const bf16_t* Wsb = (const bf16_t*)(p.ws + WS_WS) + (size_t)jl * 8 * 128 * 128;
    const float* lng = p.a_ln_g + jl * 2048; const float* lnb = p.a_ln_b + jl * 2048; const float* bs = p.a_b_s + jl * 8 * 128;
    LAS unsigned char* VN = lds;
    LAS unsigned char* WSI = lds + 67584;
    LAS float* STAT = (LAS float*)(lds + 102400);
    const int wc2 = wid & 3, wi2 = wid >> 2;
    for (int ci = blockIdx.x; ci < MT / 128; ci += gridDim.x) {
        const size_t row0 = (size_t)ci * 128;
        for (int tt = 0; tt < 16; ++tt) {
            const int j = wid * 16 + tt;
            const bf16_t* vp = Z + (row0 + j) * 4096 + 2048 + lane * 8;
            u32x4 raw[4]; float s = 0.f;
#pragma unroll
            for (int q = 0; q < 4; ++q) { raw[q] = *(const u32x4*)(vp + q * 512);
#pragma unroll
                for (int e = 0; e < 4; ++e) s += bflo(raw[q][e]) + bfhi(raw[q][e]); }
            const float mean = wave_sum(s) * (1.f / 2048.f);
            float v = 0.f;
#pragma unroll
            for (int q = 0; q < 4; ++q)
#pragma unroll
                for (int e = 0; e < 4; ++e) { const float d0 = bflo(raw[q][e]) - mean, d1 = bfhi(raw[q][e]) - mean; v += d0 * d0 + d1 * d1; }
            const float rstd = 1.0f / sqrtf(wave_sum(v) * (1.f / 2048.f) + LN_EPS);
            if (lane == 0) { STAT[j * 2] = mean; STAT[j * 2 + 1] = rstd; }
        }
        __syncthreads();
        for (int g = 0; g < 8; ++g) {
#pragma unroll
            for (int x = 0; x < 8; ++x) {
                const int q = tid + 512 * x, j = q >> 5, cc = (q & 31) * 8;
                const u32x4 raw = *(const u32x4*)(Z + (row0 + j) * 4096 + 2048 + g * 256 + cc);
                const float mean = STAT[j * 2], rstd = STAT[j * 2 + 1];
                const f32x4 g0 = *(const f32x4*)(lng + g * 256 + cc), g1 = *(const f32x4*)(lng + g * 256 + cc + 4), b0 = *(const f32x4*)(lnb + g * 256 + cc), b1 = *(const f32x4*)(lnb + g * 256 + cc + 4);
                u32x4 w;
                w.x = cvt_pk_bf16((bflo(raw.x) - mean) * rstd * g0[0] + b0[0], (bfhi(raw.x) - mean) * rstd * g0[1] + b0[1]);
                w.y = cvt_pk_bf16((bflo(raw.y) - mean) * rstd * g0[2] + b0[2], (bfhi(raw.y) - mean) * rstd * g0[3] + b0[3]);
                w.z = cvt_pk_bf16((bflo(raw.z) - mean) * rstd * g1[0] + b1[0], (bfhi(raw.z) - mean) * rstd * g1[1] + b1[1]);
                w.w = cvt_pk_bf16((bflo(raw.w) - mean) * rstd * g1[2] + b1[2], (bfhi(raw.w) - mean) * rstd * g1[3] + b1[3]);
                *(LAS u32x4*)(VN + j * 528 + cc * 2) = w;
            }
#pragma unroll
            for (int x = 0; x < 4; ++x) {
                const int q = tid + 512 * x, i = q >> 4, jc = (q & 15) * 8;
                *(LAS u32x4*)(WSI + i * 272 + jc * 2) = *(const u32x4*)(Wsb + (size_t)g * 16384 + i * 128 + jc);
            }
            __syncthreads();
            f32x4 acc[4][4];
#pragma unroll
            for (int a = 0; a < 4; ++a)
#pragma unroll
                for (int b = 0; b < 4; ++b) acc[a][b] = (f32x4){0.f, 0.f, 0.f, 0.f};
#pragma unroll
            for (int ks = 0; ks < 4; ++ks) {
                bf16x8 af[4], bf[4];
#pragma unroll
                for (int ct = 0; ct < 4; ++ct) af[ct] = frag_tr(VN, 528, ks * 32, (4 * wc2 + ct) * 16, lane);
#pragma unroll
                for (int it = 0; it < 4; ++it) bf[it] = frag_row(WSI, 272, (4 * wi2 + it) * 16, ks * 32, lane);
#pragma unroll
                for (int ct = 0; ct < 4; ++ct)
#pragma unroll
                    for (int it = 0; it < 4; ++it) acc[ct][it] = mfma16(af[ct], bf[it], acc[ct][it]);
            }
#pragma unroll
            for (int it = 0; it < 4; ++it) {
                const int i = (4 * wi2 + it) * 16 + fr; const float bsv = bs[g * 128 + i];
#pragma unroll
                for (int ct = 0; ct < 4; ++ct) {
                    bf16_t* up = Z + (row0 + i) * 4096 + g * 256 + (4 * wc2 + ct) * 16 + 4 * fq;
                    const u32x2 uu = *(const u32x2*)up;
                    const f32x4 sv = acc[ct][it] + bsv;
                    const f32x4 o = {bflo(uu.x) * sv[0], bfhi(uu.x) * sv[1], bflo(uu.y) * sv[2], bfhi(uu.y) * sv[3]};
                    *(u32x2*)up = pack4(o);
                }
            }
            __syncthreads();
        }
    }
}

__device__ __forceinline__ void retention_phase(LAS unsigned char* lds, int jl) {
    const Params p = kparams();
    const bf16_t* QKV = (const bf16_t*)(p.ws + WS_Z);
    bf16_t* O = (bf16_t*)(p.ws + WS_Z) + (size_t)HROWS * 4096;
    float* ST = (float*)(p.ws + WS_ST);
    LAS unsigned char* QH = lds;
    LAS unsigned char* KH = lds + 34816;
    LAS unsigned char* SH = lds + 69632;
    LAS unsigned char* VZ = lds + 104448;
    for (int idx = blockIdx.x; idx < 512; idx += gridDim.x) {
        const int es = idx & 3, dir = (idx >> 2) & 1, h = (idx >> 3) & 3, bl = idx >> 5;
        const float lg = log1pf(-__expf(p.b_decay[(jl * 2 + dir) * 4 + h]));
        const float gc = __expf(lg * 128.f);
        f32x4 accS[2][2][4];
#pragma unroll
        for (int a = 0; a < 2; ++a)
#pragma unroll
            for (int b = 0; b < 2; ++b)
#pragma unroll
                for (int c = 0; c < 4; ++c) accS[a][b][c] = (f32x4){0.f, 0.f, 0.f, 0.f};
        for (int step = 0; step < 18; ++step) {
            int tid_ = threadIdx.x; asm volatile("" : "+v"(tid_));
            const int tid = tid_, lane = tid & 63, wid = __builtin_amdgcn_readfirstlane(tid >> 6), fr = lane & 15, fq = lane >> 4;
            const int wlo = wid & 3, whi = wid >> 2;
            const int n = dir == 0 ? step : (step < 2 ? 1 - step : 19 - step);
            const size_t row0 = (size_t)bl * RPB + n * 128;
            f32x4 accP[4][2], accO[4][2];
#pragma unroll
            for (int a = 0; a < 4; ++a)
#pragma unroll
                for (int b = 0; b < 2; ++b) { accP[a][b] = (f32x4){0.f, 0.f, 0.f, 0.f}; accO[a][b] = (f32x4){0.f, 0.f, 0.f, 0.f}; }
#pragma unroll
            for (int x = 0; x < 4; ++x) {
                const int q = tid + 512 * x, j = q >> 4, ec = (q & 15) * 8;
                const u32x4 raw = *(const u32x4*)(QKV + (row0 + j) * 4096 + 2048 + h * 512 + es * 128 + ec);
                const float z = __expf(lg * (float)(dir ? j : 127 - j));
                u32x4 w;
                w.x = cvt_pk_bf16(bflo(raw.x) * z, bfhi(raw.x) * z); w.y = cvt_pk_bf16(bflo(raw.y) * z, bfhi(raw.y) * z);
                w.z = cvt_pk_bf16(bflo(raw.z) * z, bfhi(raw.z) * z); w.w = cvt_pk_bf16(bflo(raw.w) * z, bfhi(raw.w) * z);
                *(LAS u32x4*)(VZ + j * 272 + ec * 2) = w;
            }
#pragma unroll
            for (int dh = 0; dh < 2; ++dh) {
                {
                    const int i = tid >> 4, dc = (tid & 15) * 8;
                    const bf16_t* rp = QKV + (row0 + i) * 4096 + h * 256 + dh * 128 + dc;
                    LAS unsigned char* lq = QH + i * 272 + dc * 2;
                    u32x4 t0 = *(const u32x4*)rp, t1 = *(const u32x4*)(rp + 32 * 4096), t2 = *(const u32x4*)(rp + 64 * 4096), t3 = *(const u32x4*)(rp + 96 * 4096);
                    *(LAS u32x4*)lq = t0; *(LAS u32x4*)(lq + 32 * 272) = t1; *(LAS u32x4*)(lq + 64 * 272) = t2; *(LAS u32x4*)(lq + 96 * 272) = t3;
                    __builtin_amdgcn_sched_barrier(0);
                    t0 = *(const u32x4*)(rp + 1024); t1 = *(const u32x4*)(rp + 1024 + 32 * 4096); t2 = *(const u32x4*)(rp + 1024 + 64 * 4096); t3 = *(const u32x4*)(rp + 1024 + 96 * 4096);
                    *(LAS u32x4*)(lq + 34816) = t0; *(LAS u32x4*)(lq + 34816 + 32 * 272) = t1; *(LAS u32x4*)(lq + 34816 + 64 * 272) = t2; *(LAS u32x4*)(lq + 34816 + 96 * 272) = t3;
                    __builtin_amdgcn_sched_barrier(0);
                }
#pragma unroll
                for (int dt = 0; dt < 2; ++dt)
#pragma unroll
                    for (int et = 0; et < 4; ++et)
                        *(LAS u32x2*)(SH + ((4 * whi + et) * 16 + fr) * 272 + ((2 * wlo + dt) * 16 + 4 * fq) * 2) = pack4(accS[dh][dt][et]);
                __syncthreads();
#pragma unroll
                for (int ks = 0; ks < 4; ++ks) {
                    bf16x8 qf[2], kf[4];
#pragma unroll
                    for (int it = 0; it < 2; ++it) qf[it] = frag_row(QH, 272, (2 * wlo + it) * 16, ks * 32, lane);
#pragma unroll
                    for (int jt = 0; jt < 4; ++jt) kf[jt] = frag_row(KH, 272, (4 * whi + jt) * 16, ks * 32, lane);
#pragma unroll
                    for (int jt = 0; jt < 4; ++jt)
#pragma unroll
                        for (int it = 0; it < 2; ++it) accP[jt][it] = mfma16(kf[jt], qf[it], accP[jt][it]);
                    __builtin_amdgcn_sched_barrier(0);
                }
#pragma unroll
                for (int ks = 0; ks < 4; ++ks) {
                    bf16x8 qf[2], sf[4];
#pragma unroll
                    for (int it = 0; it < 2; ++it) qf[it] = frag_row(QH, 272, (2 * wlo + it) * 16, ks * 32, lane);
#pragma unroll
                    for (int et = 0; et < 4; ++et) sf[et] = frag_row(SH, 272, (4 * whi + et) * 16, ks * 32, lane);
#pragma unroll
                    for (int et = 0; et < 4; ++et)
#pragma unroll
                        for (int it = 0; it < 2; ++it) accO[et][it] = mfma16(sf[et], qf[it], accO[et][it]);
                    __builtin_amdgcn_sched_barrier(0);
                }
#pragma unroll
                for (int dt = 0; dt < 2; ++dt)
#pragma unroll
                    for (int et = 0; et < 4; ++et) accS[dh][dt][et] = accS[dh][dt][et] * gc;
#pragma unroll
                for (int ks = 0; ks < 4; ++ks) {
                    bf16x8 kt[2], vt[4];
#pragma unroll
                    for (int dt = 0; dt < 2; ++dt) kt[dt] = frag_tr(KH, 272, ks * 32, (2 * wlo + dt) * 16, lane);
#pragma unroll
                    for (int et = 0; et < 4; ++et) vt[et] = frag_tr(VZ, 272, ks * 32, (4 * whi + et) * 16, lane);
#pragma unroll
                    for (int dt = 0; dt < 2; ++dt)
#pragma unroll
                        for (int et = 0; et < 4; ++et) accS[dh][dt][et] = mfma16(kt[dt], vt[et], accS[dh][dt][et]);
                    __builtin_amdgcn_sched_barrier(0);
                }
                __syncthreads();
            }
#pragma unroll
            for (int it = 0; it < 2; ++it) {
                const int i = (2 * wlo + it) * 16 + fr;
                const float xi = __expf(lg * (float)(dir ? 128 - i : i + 1));
                const float mk = __expf(lg * (float)(dir ? -i : i - 127));
#pragma unroll
                for (int et = 0; et < 4; ++et) accO[et][it] = accO[et][it] * xi;
#pragma unroll
                for (int jt = 0; jt < 4; ++jt) {
                    const int j0 = (4 * whi + jt) * 16 + 4 * fq;
                    f32x4 pv; const int d0 = dir ? (j0 - i) : (i - j0), ds = dir ? 1 : -1;
#pragma unroll
                    for (int r = 0; r < 4; ++r) { const float mr = fminf(fmaxf((float)(d0 + r * ds + 1), 0.f), 1.f); pv[r] = accP[jt][it][r] * (mk * mr); }
                    *(LAS u32x2*)(QH + i * 272 + j0 * 2) = pack4(pv);
                }
            }
            __syncthreads();
#pragma unroll
            for (int ks = 0; ks < 4; ++ks) {
                bf16x8 pf[2], vt[4];
#pragma unroll
                for (int it = 0; it < 2; ++it) pf[it] = frag_row(QH, 272, (2 * wlo + it) * 16, ks * 32, lane);
#pragma unroll
                for (int et = 0; et < 4; ++et) vt[et] = frag_tr(VZ, 272, ks * 32, (4 * whi + et) * 16, lane);
#pragma unroll
                for (int et = 0; et < 4; ++et)
#pragma unroll
                    for (int it = 0; it < 2; ++it) accO[et][it] = mfma16(vt[et], pf[it], accO[et][it]);
                __builtin_amdgcn_sched_barrier(0);
            }
#pragma unroll
            for (int it = 0; it < 2; ++it) {
                const size_t row = row0 + (2 * wlo + it) * 16 + fr;
                float s = 0.f, q2 = 0.f;
#pragma unroll
                for (int et = 0; et < 4; ++et) {
                    const f32x4 v = accO[et][it];
                    s += (v[0] + v[1]) + (v[2] + v[3]); q2 += (v[0] * v[0] + v[1] * v[1]) + (v[2] * v[2] + v[3] * v[3]);
                    *(u32x2*)(O + row * 4096 + dir * 2048 + h * 512 + es * 128 + (4 * whi + et) * 16 + 4 * fq) = pack4(v);
                }
                s += __shfl_xor(s, 16); s += __shfl_xor(s, 32); q2 += __shfl_xor(q2, 16); q2 += __shfl_xor(q2, 32);
                if (fq == 0) *(f32x2*)(ST + ((row * 4 + h) * 2 + dir) * 16 + (es * 2 + whi) * 2) = (f32x2){s, q2};
            }
            __syncthreads();
        }
    }
}

__device__ __forceinline__ void gemm_a_in(LAS unsigned char* lds, int jl) {
    const Params p = kparams(); unsigned char* ws = p.ws;
    EpiAct<1> E{(bf16_t*)(ws + WS_Z), 4096, p.a_b_in + jl * 4096};
    run_gemm(lds, (const bf16_t*)(ws + WS_H), 1024, (const bf16_t*)(ws + WS_WA_IN + jl * SZ_W4), 1024, MT / 256, 16, 0, 0, E);
}
__device__ __forceinline__ void gemm_out(LAS unsigned char* lds, size_t w_off, int K, int hb, int mode) {
    const Params p = kparams(); unsigned char* ws = p.ws;
    EpiAct<0> E{(bf16_t*)(ws + WS_H), 1024, nullptr};
    const bf16_t* Z = (const bf16_t*)(ws + WS_Z);
    const bf16_t* A = (mode == 1 || mode == 2) ? Z + (ptrdiff_t)HROWS * 4096 - (ptrdiff_t)hb * HROWS * 4096 : Z;
    const int nM = mode == 0 ? 288 : mode == 1 ? 144 : mode == 2 ? 128 : 256;
    run_gemm(lds, A, 4096, (const bf16_t*)(ws + w_off), K, nM, 4, (mode == 1 || mode == 2) ? hb * 144 : 0, mode >= 2 ? 1 : 0, E);
}
__device__ __forceinline__ void gemm_qkv(LAS unsigned char* lds, int jl, int hb) {
    const Params p = kparams(); unsigned char* ws = p.ws;
    const float* rc = (const float*)(ws + WS_ROPE);
    EpiQKV E{(bf16_t*)(ws + WS_Z) - (ptrdiff_t)hb * HROWS * 4096, rc, rc + 2048 * 128};
    run_gemm(lds, (const bf16_t*)(ws + WS_H), 1024, (const bf16_t*)(ws + WS_WB_QKV + jl * SZ_W4), 1024, 144, 16, hb * 144, 0, E);
}
__device__ __forceinline__ void gemm_gate(LAS unsigned char* lds, int jl, int hb, bool last) {
    const Params p = kparams(); unsigned char* ws = p.ws;
    EpiGate E{(bf16_t*)(ws + WS_Z) + (ptrdiff_t)HROWS * 4096 - (ptrdiff_t)hb * HROWS * 4096, (const float*)(ws + WS_ST) - (ptrdiff_t)hb * HROWS * 128};
    run_gemm(lds, (const bf16_t*)(ws + WS_H), 1024, (const bf16_t*)(ws + WS_WB_GATE + jl * SZ_W4), 1024, last ? 128 : 144, 16, hb * 144, last ? 1 : 0, E);
}
__device__ __forceinline__ void gemm_w1(LAS unsigned char* lds, int l, bool last) {
    const Params p = kparams(); unsigned char* ws = p.ws;
    EpiAct<2> E{(bf16_t*)(ws + WS_Z), 4096, nullptr};
    run_gemm(lds, (const bf16_t*)(ws + WS_H), 1024, (const bf16_t*)(ws + WS_W1 + l * SZ_W4), 1024, last ? 256 : 288, 16, 0, last ? 1 : 0, E);
}

__global__ void __launch_bounds__(NTHR, 2) fwd_kernel(Params pdummy) {
    extern __shared__ __attribute__((aligned(16))) unsigned char smem[];
    LAS unsigned char* lds = (LAS unsigned char*)smem;
    cg::grid_group grid = cg::this_grid();
    prologue0(lds);
    grid.sync();
    prologue1();
    grid.sync();
#pragma unroll 1
    for (int l = 0; l < 4; ++l) {
        const int jl = l >> 1; const bool last = (l == 3);
        if ((l & 1) == 0) {
            gemm_a_in(lds, jl);
            grid.sync();
            gating_phase(lds, jl);
            grid.sync();
            gemm_out(lds, WS_WA_OUT + jl * (SZ_W4 / 2), 2048, 0, 0);
            grid.sync();
        } else {
#pragma unroll 1
            for (int hb = 0; hb < 2; ++hb) {
                gemm_qkv(lds, jl, hb);
                grid.sync();
                retention_phase(lds, jl);
                grid.sync();
                gemm_gate(lds, jl, hb, last);
                grid.sync();
                gemm_out(lds, WS_WB_OUT + jl * (SZ_W4 / 2), 2048, hb, last ? 2 : 1);
                grid.sync();
            }
        }
        ln_phase(l, 0, last);
        grid.sync();
        gemm_w1(lds, l, last);
        grid.sync();
        gemm_out(lds, WS_W2 + l * SZ_W4, 4096, 0, last ? 3 : 0);
        grid.sync();
        ln_phase(l, 1, last);
        if (!last) grid.sync();
    }
}

extern "C" void kernel_launch(void* const* d_in, const int* in_sizes, int n_in, void* d_out, int out_size, void* d_ws, size_t ws_size, hipStream_t stream) {
    static int grid = 0;
    if (grid == 0) {
        if (n_in != 22 || ws_size < WS_END) { fprintf(stderr, "kernel_launch: need 22 inputs and %zu bytes of workspace (got %d, %zu)\n", (size_t)WS_END, n_in, ws_size); grid = -1; return; }
        int dev = 0, cus = 0, per_cu = 0;
        (void)hipGetDevice(&dev); (void)hipDeviceGetAttribute(&cus, hipDeviceAttributeMultiprocessorCount, dev);
        if (hipFuncSetAttribute((const void*)fwd_kernel, hipFuncAttributeMaxDynamicSharedMemorySize, LDS_BYTES) != hipSuccess) fprintf(stderr, "kernel_launch: hipFuncSetAttribute failed\n");
        if (hipOccupancyMaxActiveBlocksPerMultiprocessor(&per_cu, (const void*)fwd_kernel, NTHR, LDS_BYTES) != hipSuccess || per_cu < 1) fprintf(stderr, "kernel_launch: occupancy query says %d blocks per CU\n", per_cu);
        (void)hipGetLastError();
        grid = cus > 0 ? cus : 256;
    }
    if (grid < 0) return;
    Params p{};
    const float** pp = (const float**)&p;
    for (int i = 0; i < 22; ++i) pp[i] = (const float*)d_in[i];
    p.out = (float*)d_out; p.ws = (unsigned char*)d_ws;
    void* args[] = {&p};
    const hipError_t e = hipLaunchCooperativeKernel((const void*)fwd_kernel, dim3(grid), dim3(NTHR), args, LDS_BYTES, stream);
    if (e != hipSuccess) fprintf(stderr, "kernel_launch: cooperative launch failed: %s (grid %d)\n", hipGetErrorString(e), grid);
}
```

```cpp
#include <hip/hip_runtime.h>
#include <hip/hip_cooperative_groups.h>
#include <cstdio>
#include <cstdint>
#include <cstddef>
namespace pg8 {
#define PG8_LAS __attribute__((address_space(3)))
typedef unsigned short bf16_t;
typedef short bf16x8 __attribute__((ext_vector_type(8)));
typedef float f32x4 __attribute__((ext_vector_type(4)));
typedef unsigned u32x4 __attribute__((ext_vector_type(4)));
constexpr int BM = 256, BK = 64, HALF = 128, HTB = HALF * BK * 2  , STAGE_BYTES = 8 * HTB, NXCD = 8, WGM = 8;

__host__ __device__ __forceinline__ int lds_byte(int r, int c) { const int st = (r >> 4) * 2 + (c >> 5), rr = r & 15, cc = c & 31, ob = rr * 64 + cc * 2; return st * 1024 + (ob ^ (((ob >> 9) & 1) << 5)); }
__host__ __device__ __forceinline__ void stage_rc(int b, int& R, int& C) { const int st = b / 1024, sb = b % 1024, swz = sb ^ (((sb >> 9) & 1) << 5); R = (st >> 1) * 16 + swz / 64; C = (st & 1) * 32 + (swz % 64) / 2; }
__host__ __device__ __forceinline__ int perm32(int rho) { const int n = rho >> 4, i = rho & 15; return 8 * (i >> 2) + 4 * n + (i & 3); }

struct Unit { int pm, pn; };
struct Gemm { const bf16_t* A; const bf16_t* Bt; int K, lda, ldb; };


__device__ __forceinline__ unsigned cvt_pk_bf16(float lo, float hi) { unsigned r; asm volatile("v_cvt_pk_bf16_f32 %0, %1, %2" : "=v"(r) : "v"(lo), "v"(hi)); return r; }
typedef float f32x2 __attribute__((ext_vector_type(2)));
__device__ __forceinline__ f32x2 gelu_pk(f32x2 v) {
    const f32x2 av = __builtin_elementwise_abs(v), d = av * 0.2316418882f + 1.0f;
    f32x2 t; t.x = __builtin_amdgcn_rcpf(d.x); t.y = __builtin_amdgcn_rcpf(d.y);
    f32x2 q = t * 0.5307027145f + (-0.7265760135f); q = q * t + 0.7107068705f; q = q * t + (-0.142248368f); q = q * t + 0.127414796f; q = q * t;
    const f32x2 s = (v * v) * (-0.72134752044f);
    f32x2 e; e.x = __builtin_amdgcn_exp2f(s.x); e.y = __builtin_amdgcn_exp2f(s.y);
    const f32x2 m = v * (q * e), r = v - m;
    f32x2 o; o.x = v.x < 0.f ? m.x : r.x; o.y = v.y < 0.f ? m.y : r.y; return o;
}


template <class Epi, class Sched, bool ALIGN_EPI = false, bool SP2 = false>
__device__ __forceinline__ void gemm_phase(PG8_LAS unsigned char* lds, const Gemm g, const Sched& S, const Epi& E) {
    int tid_ = threadIdx.x; asm volatile("" : "+v"(tid_));
    const int tid = tid_, wid = __builtin_amdgcn_readfirstlane(tid >> 6), lane = tid & 63, wr = wid >> 2, wc = wid & 3, fr = lane & 15, fq = lane >> 4;
    const int K = g.K, nt = K / BK;
    unsigned voffA[2], voffB[2];
#pragma unroll
    for (int i = 0; i < 2; ++i) { int R, C; stage_rc(tid * 16 + i * 8192, R, C); const int Rb = Epi::PERM ? ((R & ~31) + perm32(R & 31)) : R;
        voffA[i] = (unsigned)(R * g.lda + C) * 2u; voffB[i] = (unsigned)(Rb * g.ldb + C) * 2u; }
    const size_t kstep = (size_t)(BK * 2);
    const size_t hstepA = (size_t)HALF * g.lda * 2, hstepB = (size_t)HALF * g.ldb * 2;
    const size_t tstepA = 2 * hstepA, tstepB = 2 * hstepB;
    const unsigned ldsw = (unsigned)wid * 1024u;
    const int aoff = lds_byte(wr * 64 + fr, fq * 8), boff = lds_byte(wc * 32 + fr, fq * 8);
#define PG8_SA(b, h) (((b) * 2 + (h)) * HTB)
#define PG8_SB(b, h) ((4 + (b) * 2 + (h)) * HTB)
#define PG8_STAGE(bufoff, gbase, voff) do { _Pragma("unroll") for (int _i = 0; _i < 2; ++_i) \
        __builtin_amdgcn_global_load_lds((const unsigned*)((const char*)(gbase) + (voff)[_i]), (PG8_LAS unsigned*)(lds + (bufoff) + ldsw + _i * 8192), 16, 0, 0); } while (0)
#define PG8_LDA(dst, b, h) do { _Pragma("unroll") for (int m = 0; m < 4; ++m) _Pragma("unroll") for (int k = 0; k < 2; ++k) dst[m][k] = *(const PG8_LAS bf16x8*)(lds + PG8_SA(b, h) + aoff + m * 2048 + k * 1024); } while (0)
#define PG8_LDB(dst, b, h) do { _Pragma("unroll") for (int n = 0; n < 2; ++n) _Pragma("unroll") for (int k = 0; k < 2; ++k) dst[n][k] = *(const PG8_LAS bf16x8*)(lds + PG8_SB(b, h) + boff + n * 2048 + k * 1024); } while (0)
#define PG8_MMA(ai, bj, At, Bt) do { __builtin_amdgcn_s_setprio(1); _Pragma("unroll") for (int m = 0; m < 4; ++m) _Pragma("unroll") for (int n = 0; n < 2; ++n) _Pragma("unroll") for (int k = 0; k < 2; ++k) \
        acc[ai][bj][m][n] = __builtin_amdgcn_mfma_f32_16x16x32_bf16(Bt[n][k], At[m][k], acc[ai][bj][m][n], 0, 0, 0); __builtin_amdgcn_s_setprio(0); } while (0)
#define PG8_WAIT_V(n) asm volatile("s_waitcnt vmcnt(" #n ")" ::: "memory")
#define PG8_WAIT_L(n) asm volatile("s_waitcnt lgkmcnt(" #n ")" ::: "memory")
#define PG8_BAR __builtin_amdgcn_s_barrier()
#define PG8_SCHED __builtin_amdgcn_sched_barrier(0)
    Unit cur, nxt; int ui = 0;
    if (!S.next(0, cur)) return;
    f32x4 acc[2][2][4][2];
#pragma unroll
    for (int a = 0; a < 2; ++a)
#pragma unroll
        for (int b = 0; b < 2; ++b)
#pragma unroll
            for (int m = 0; m < 4; ++m)
#pragma unroll
                for (int n = 0; n < 2; ++n) acc[a][b][m][n] = (f32x4){0.f, 0.f, 0.f, 0.f};
    bf16x8 At[4][2], B0[2][2], B1[2][2];
    const char* cA = (const char*)g.A + (size_t)cur.pm * tstepA; const char* cB = (const char*)g.Bt + (size_t)cur.pn * tstepB;
    S.a_ready(cur);
    if constexpr (SP2) {
        PG8_STAGE(PG8_SB(0, 0), cB, voffB); PG8_STAGE(PG8_SB(0, 1), cB + hstepB, voffB); PG8_STAGE(PG8_SA(0, 0), cA, voffA); PG8_STAGE(PG8_SA(0, 1), cA + hstepA, voffA);
        if (wr == 1) PG8_BAR;
        PG8_WAIT_V(2); PG8_BAR;
        PG8_STAGE(PG8_SB(1, 0), cB + kstep, voffB); PG8_STAGE(PG8_SA(1, 0), cA + kstep, voffA); PG8_STAGE(PG8_SB(1, 1), cB + hstepB + kstep, voffB);
        PG8_WAIT_V(6); PG8_BAR;
    } else {
        PG8_STAGE(PG8_SB(0, 0), cB, voffB); PG8_STAGE(PG8_SA(0, 0), cA, voffA); PG8_STAGE(PG8_SB(0, 1), cB + hstepB, voffB); PG8_STAGE(PG8_SA(0, 1), cA + hstepA, voffA);
        if (wr == 1) PG8_BAR;
        PG8_WAIT_V(4); PG8_BAR;
        PG8_STAGE(PG8_SB(1, 0), cB + kstep, voffB); PG8_STAGE(PG8_SA(1, 0), cA + kstep, voffA); PG8_STAGE(PG8_SB(1, 1), cB + hstepB + kstep, voffB);
        PG8_WAIT_V(6); PG8_BAR;
    }
    for (;;) {
        const bool has_next = S.next(ui + 1, nxt);
        const char* nA = has_next ? (const char*)g.A + (size_t)nxt.pm * tstepA : cA; const char* nB = has_next ? (const char*)g.Bt + (size_t)nxt.pn * tstepB : cB;
        for (int t = 0; t < nt; t += 2) {
            const bool last = (t == nt - 2);
            const char* a1 = cA + (size_t)(t + 1) * kstep;
            const char* a2 = last ? nA : cA + (size_t)(t + 2) * kstep; const char* b2 = last ? nB : cB + (size_t)(t + 2) * kstep;
            const char* a3 = a2 + kstep; const char* b3 = b2 + kstep;
            if (last && has_next) S.a_ready(nxt);
            if constexpr (SP2) {
            PG8_LDB(B0, 0, 0); PG8_LDB(B1, 0, 1); PG8_SCHED; PG8_LDA(At, 0, 0); PG8_STAGE(PG8_SA(1, 1), a1 + hstepA, voffA);
            PG8_WAIT_V(8); PG8_WAIT_L(0); PG8_BAR; PG8_MMA(0, 0, At, B0); PG8_MMA(0, 1, At, B1); PG8_BAR; PG8_SCHED;
            PG8_LDA(At, 0, 1); PG8_STAGE(PG8_SB(0, 0), b2, voffB); PG8_STAGE(PG8_SB(0, 1), b2 + hstepB, voffB); PG8_STAGE(PG8_SA(0, 0), a2, voffA);
            PG8_WAIT_V(8); PG8_WAIT_L(0); PG8_BAR; PG8_MMA(1, 0, At, B0); PG8_MMA(1, 1, At, B1); PG8_BAR; PG8_SCHED;
            PG8_LDB(B0, 1, 0); PG8_LDB(B1, 1, 1); PG8_SCHED; PG8_LDA(At, 1, 0); PG8_STAGE(PG8_SA(0, 1), a2 + hstepA, voffA);
            PG8_WAIT_V(8); PG8_WAIT_L(0); PG8_BAR; PG8_MMA(0, 0, At, B0); PG8_MMA(0, 1, At, B1); PG8_BAR; PG8_SCHED;
            PG8_LDA(At, 1, 1); PG8_STAGE(PG8_SB(1, 0), b3, voffB); PG8_STAGE(PG8_SB(1, 1), b3 + hstepB, voffB); PG8_STAGE(PG8_SA(1, 0), a3, voffA);
            PG8_WAIT_V(8); PG8_WAIT_L(0); PG8_BAR; PG8_MMA(1, 0, At, B0); PG8_MMA(1, 1, At, B1); PG8_BAR; PG8_SCHED;
            } else {
            PG8_LDB(B0, 0, 0); PG8_SCHED; PG8_LDA(At, 0, 0); PG8_STAGE(PG8_SA(1, 1), a1 + hstepA, voffA);
            PG8_WAIT_L(8); PG8_BAR; PG8_WAIT_L(0); PG8_MMA(0, 0, At, B0); PG8_BAR; PG8_SCHED;
            PG8_LDB(B1, 0, 1); PG8_STAGE(PG8_SB(0, 0), b2, voffB);
            PG8_BAR; PG8_WAIT_L(0); PG8_MMA(0, 1, At, B1); PG8_BAR;
            PG8_LDA(At, 0, 1); PG8_STAGE(PG8_SA(0, 0), a2, voffA);
            PG8_BAR; PG8_WAIT_L(0); PG8_MMA(1, 0, At, B0); PG8_BAR; PG8_SCHED;
            PG8_STAGE(PG8_SB(0, 1), b2 + hstepB, voffB);
            PG8_WAIT_V(6); PG8_BAR; PG8_MMA(1, 1, At, B1); PG8_BAR;
            PG8_LDB(B0, 1, 0); PG8_SCHED; PG8_LDA(At, 1, 0); PG8_STAGE(PG8_SA(0, 1), a2 + hstepA, voffA);
            PG8_WAIT_L(8); PG8_BAR; PG8_WAIT_L(0); PG8_MMA(0, 0, At, B0); PG8_BAR; PG8_SCHED;
            PG8_LDB(B1, 1, 1); PG8_STAGE(PG8_SB(1, 0), b3, voffB);
            PG8_BAR; PG8_WAIT_L(0); PG8_MMA(0, 1, At, B1); PG8_BAR;
            PG8_LDA(At, 1, 1); PG8_STAGE(PG8_SA(1, 0), a3, voffA);
            PG8_BAR; PG8_WAIT_L(0); PG8_MMA(1, 0, At, B0); PG8_BAR; PG8_SCHED;
            PG8_STAGE(PG8_SB(1, 1), b3 + hstepB, voffB);
            PG8_WAIT_V(6); PG8_BAR; PG8_MMA(1, 1, At, B1); PG8_BAR;
            }
        }
        if constexpr (ALIGN_EPI) { if (wr == 0) PG8_BAR; }
        if constexpr (!Epi::AFTER_DRAIN) { E(acc, cur, wr, wc, fr, fq); S.done(cur); }
        if (!has_next) break;
#pragma unroll
        for (int a = 0; a < 2; ++a)
#pragma unroll
            for (int b = 0; b < 2; ++b)
#pragma unroll
                for (int m = 0; m < 4; ++m)
#pragma unroll
                    for (int n = 0; n < 2; ++n) acc[a][b][m][n] = (f32x4){0.f, 0.f, 0.f, 0.f};
        cur = nxt; cA = nA; cB = nB; ++ui;
        if constexpr (ALIGN_EPI) { if (wr == 1) PG8_BAR; }
    }
    PG8_WAIT_V(0);
    if constexpr (!ALIGN_EPI) { if (wr == 0) PG8_BAR; }
    PG8_BAR;
    if constexpr (Epi::AFTER_DRAIN) { E.fused(acc, cur, wr, wc, fr, fq, lds, wid, lane); S.done(cur); }
#undef PG8_SA
#undef PG8_SB
#undef PG8_STAGE
#undef PG8_LDA
#undef PG8_LDB
#undef PG8_MMA
#undef PG8_WAIT_V
#undef PG8_WAIT_L
#undef PG8_BAR
#undef PG8_SCHED
}
}

namespace cg = cooperative_groups;
using pg8::bf16_t; using pg8::bf16x8; using pg8::f32x4; using pg8::u32x4; using pg8::f32x2; using pg8::Unit; using pg8::cvt_pk_bf16;
#define LAS __attribute__((address_space(3)))
typedef short s16x4 __attribute__((ext_vector_type(4)));
typedef unsigned u32x2 __attribute__((ext_vector_type(2)));

constexpr int DM = 1024, NB = 32, RPB = 2304, MT = NB * RPB;
constexpr int HROWS = MT / 2;
constexpr int NTHR = 512, LDS_BYTES = 147456;
constexpr float LN_EPS = 1e-5f;
constexpr float DN_ALPHA = 1.6817928305074290f;

constexpr size_t SZ_W4 = (size_t)4096 * 1024 * 2;
constexpr size_t WS_MOD = 4096;
constexpr size_t WS_ROPE = WS_MOD + (size_t)4 * 33 * 6144 * 4;
constexpr size_t WS_CX = WS_ROPE + (size_t)2 * 2048 * 128 * 4;
constexpr size_t WS_WA_IN = WS_CX + (size_t)32 * 256 * 1024 * 4;
constexpr size_t WS_WA_OUT = WS_WA_IN + 2 * SZ_W4;
constexpr size_t WS_WB_QKV = WS_WA_OUT + SZ_W4;
constexpr size_t WS_WB_GATE = WS_WB_QKV + 2 * SZ_W4;
constexpr size_t WS_WB_OUT = WS_WB_GATE + 2 * SZ_W4;
constexpr size_t WS_W1 = WS_WB_OUT + SZ_W4;
constexpr size_t WS_W2 = WS_W1 + 4 * SZ_W4;
constexpr size_t WS_WS = WS_W2 + 4 * SZ_W4;
constexpr size_t WS_H = WS_WS + (size_t)2 * 8 * 128 * 128 * 2;
constexpr size_t WS_Z = WS_H + (size_t)MT * 1024 * 2;
constexpr size_t WS_ST = WS_Z + (size_t)MT * 4096 * 2;
constexpr size_t WS_BAR = WS_ST + (size_t)HROWS * 128 * 4;
constexpr size_t WS_END = WS_BAR + 16384;
constexpr int MODN = 4 * 33 * 6144;

struct Params {
    const float *x, *c, *ctx, *c_ctx, *ada_w, *ada_b, *ln1_g, *ln1_b, *ln2_g, *ln2_b, *ffn_w1, *ffn_w2, *a_w_in, *a_b_in, *a_ln_g, *a_ln_b, *a_w_s, *a_b_s, *a_w_out, *b_w_in, *b_decay, *b_w_out;
    float* out; unsigned char* ws;
};
typedef const unsigned long long __attribute__((address_space(4)))* KP64;
__device__ __forceinline__ Params kparams() {
    Params r;
#if defined(__HIP_DEVICE_COMPILE__)
    KP64 kp = (KP64)__builtin_amdgcn_kernarg_segment_ptr(); asm volatile("" : "+s"(kp));
    unsigned long long* d = (unsigned long long*)&r;
#pragma unroll
    for (int i = 0; i < (int)(sizeof(Params) / 8); ++i) d[i] = kp[i];
#endif
    return r;
}

__device__ __forceinline__ float bflo(unsigned w) { return __uint_as_float(w << 16); }
__device__ __forceinline__ float bfhi(unsigned w) { return __uint_as_float(w & 0xffff0000u); }
__device__ __forceinline__ float silu_f(float x) { return x / (1.f + __expf(-x)); }
__device__ __forceinline__ float wave_sum(float v) {
#pragma unroll
    for (int o = 32; o >= 1; o >>= 1) v += __shfl_xor(v, o);
    return v;
}
__device__ __forceinline__ f32x4 mfma16(bf16x8 a, bf16x8 b, f32x4 c) { return __builtin_amdgcn_mfma_f32_16x16x32_bf16(a, b, c, 0, 0, 0); }
__device__ __forceinline__ bf16x8 frag_tr(const LAS unsigned char* T, int ld, int k0, int x0, int lane) {
    const int fq = lane >> 4, li = lane & 15, q = li >> 2, p = li & 3;
    const LAS unsigned char* a = T + (k0 + 8 * fq + q) * ld + (x0 + 4 * p) * 2;
    const s16x4 lo = __builtin_amdgcn_ds_read_tr16_b64_v4i16((LAS s16x4*)a);
    const s16x4 hi = __builtin_amdgcn_ds_read_tr16_b64_v4i16((LAS s16x4*)(a + 4 * ld));
    bf16x8 r; r[0] = lo[0]; r[1] = lo[1]; r[2] = lo[2]; r[3] = lo[3]; r[4] = hi[0]; r[5] = hi[1]; r[6] = hi[2]; r[7] = hi[3];
    return r;
}
__device__ __forceinline__ bf16x8 frag_row(const LAS unsigned char* T, int ld, int x0, int k0, int lane) {
    return *(const LAS bf16x8*)(T + (x0 + (lane & 15)) * ld + (k0 + 8 * (lane >> 4)) * 2);
}
__device__ __forceinline__ u32x2 pack4(f32x4 v) { u32x2 w; w.x = cvt_pk_bf16(v[0], v[1]); w.y = cvt_pk_bf16(v[2], v[3]); return w; }

#define XB_TMO      128
#define XB_XCNT(j)  (256  + 64 * (j))
#define XB_XSUB(j)  (1280 + 64 * (j))
#define XB_XGEN(j)  (2304 + 64 * (j))
#define XB_TOP      3328
#define XB_TOPGEN   3392
#define XCD_BAR_WORDS 3456
#define XB_SPIN_CAP (1u << 18)

__device__ __forceinline__ unsigned xb_ld(unsigned* p)              { return __hip_atomic_load(p, __ATOMIC_RELAXED, __HIP_MEMORY_SCOPE_AGENT); }
__device__ __forceinline__ unsigned xb_add(unsigned* p, unsigned v) { return __hip_atomic_fetch_add(p, v, __ATOMIC_RELAXED, __HIP_MEMORY_SCOPE_AGENT); }
__device__ __forceinline__ unsigned xb_xcc_id() { return (unsigned)__builtin_amdgcn_s_getreg((3 << 11) | 20) & 0xFu; }
#define XB_SPIN(cond, bar) do { unsigned _sp = 0; while (cond) { __builtin_amdgcn_s_sleep(1); \
    if ((++_sp & 255u) == 0u) { if (xb_ld(&(bar)[XB_TMO])) break; if (_sp > XB_SPIN_CAP) { atomicAdd(&(bar)[XB_TMO], 1u); break; } } } } while (0)

struct XcdBarrier {
    unsigned* bar; unsigned x;
    volatile LAS unsigned* st;
};

__device__ __forceinline__ XcdBarrier xcd_barrier_post(unsigned* bar, volatile LAS unsigned* st) {
    XcdBarrier b; b.bar = bar; b.x = xb_xcc_id(); b.st = st;
    if (threadIdx.x == 0) (void)xb_add(&bar[XB_XCNT(b.x)], 1u);
    return b;
}
__device__ __forceinline__ void xcd_barrier_complete(unsigned* bar, unsigned x, unsigned& nloc, unsigned& nx) {
    const unsigned G = gridDim.x * gridDim.y * gridDim.z;
    unsigned sum, cnt, mine, sp = 0u;
    for (;;) {
        sum = 0u; cnt = 0u; mine = 0u;
#pragma unroll
        for (unsigned j = 0; j < 16; ++j) { const unsigned c = xb_ld(&bar[XB_XCNT(j)]); sum += c; cnt += (c > 0u) ? 1u : 0u; mine = (j == x) ? c : mine; }
        if (sum == G) break;
        __builtin_amdgcn_s_sleep(1);
        if ((++sp & 255u) == 0u) { if (xb_ld(&bar[XB_TMO])) break; if (sp > XB_SPIN_CAP) { atomicAdd(&bar[XB_TMO], 1u); break; } }
    }
    nloc = mine > 0u ? mine : 1u; nx = cnt > 0u ? cnt : 1u;
}

__device__ __forceinline__ void xcd_barrier(const XcdBarrier& b) {
    asm volatile("s_waitcnt vmcnt(0)" ::: "memory");
    __syncthreads();
    if (threadIdx.x == 0) {
        unsigned* bar = b.bar;
        __builtin_amdgcn_s_waitcnt(0);
        unsigned nloc = b.st[0], nx = b.st[1];
        if (nloc == 0u) { xcd_barrier_complete(bar, b.x, nloc, nx); b.st[0] = nloc; b.st[1] = nx; }
        const unsigned old = xb_add(&bar[XB_XSUB(b.x)], 1u);
        const unsigned gen = old / nloc;
        if (old + 1u == (gen + 1u) * nloc) {
            __builtin_amdgcn_fence(__ATOMIC_RELEASE, "agent");
            asm volatile("s_waitcnt vmcnt(0)" ::: "memory");
            const unsigned og = xb_add(&bar[XB_TOP], 1u);
            const unsigned tg = og / nx;
            if (og + 1u == (tg + 1u) * nx) xb_add(&bar[XB_TOPGEN], 1u);
            else XB_SPIN(xb_ld(&bar[XB_TOPGEN]) == tg, bar);
            __builtin_amdgcn_fence(__ATOMIC_ACQUIRE, "agent");
            xb_add(&bar[XB_XGEN(b.x)], 1u);
            asm volatile("s_waitcnt vmcnt(0)" ::: "memory");
        } else {
            XB_SPIN(xb_ld(&bar[XB_XGEN(b.x)]) == gen, bar);
            __builtin_amdgcn_fence(__ATOMIC_ACQUIRE, "agent");
            asm volatile("s_waitcnt vmcnt(0)" ::: "memory");
        }
    }
    __syncthreads();
}

struct Sched {
    int nM, nN, nwg, G, c, pm_off, skip;
    __device__ void init(int nM_, int nN_, int G_, int c_, int pm_off_, int skip_) { nM = nM_; nN = nN_; nwg = nM * nN; G = G_; c = c_; pm_off = pm_off_; skip = skip_; }
    __device__ bool next(int i, Unit& u) const {
        const long L = (long)i * G + c; if (L >= nwg) return false;
        int wgid = (int)L; { const int q = nwg / pg8::NXCD, r = nwg % pg8::NXCD, xcd = wgid % pg8::NXCD, off = wgid / pg8::NXCD; wgid = (xcd < r ? xcd * (q + 1) : r * (q + 1) + (xcd - r) * q) + off; }
        const int nig = pg8::WGM * nN, gid = wgid / nig, fm = gid * pg8::WGM, gsz = (nM - fm) < pg8::WGM ? (nM - fm) : pg8::WGM;
        int pm = fm + ((wgid % nig) % gsz); u.pn = (wgid % nig) / gsz;
        if (skip) pm = (pm >> 3) * 9 + 1 + (pm & 7);
        u.pm = pm + pm_off; return true;
    }
    __device__ __forceinline__ void a_ready(const Unit&) const {}
    __device__ __forceinline__ void done(const Unit&) const {}
};

template <int ACT> struct EpiAct {
    static constexpr bool PERM = true, AFTER_DRAIN = false;
    bf16_t* O; int ldc; const float* bias;
    __device__ __forceinline__ void operator()(const f32x4 (&acc)[2][2][4][2], const Unit& u, int wr, int wc, int fr, int fq) const {
        const int row0 = u.pm * 256 + wr * 64 + fr, col0 = u.pn * 256 + wc * 32 + 8 * fq;
        f32x4 bv[2][2];
#pragma unroll
        for (int bj = 0; bj < 2; ++bj)
#pragma unroll
            for (int n = 0; n < 2; ++n) bv[bj][n] = (ACT == 1) ? *(const f32x4*)(bias + col0 + bj * 128 + 4 * n) : (f32x4){0.f, 0.f, 0.f, 0.f};
#pragma unroll
        for (int ai = 0; ai < 2; ++ai)
#pragma unroll
            for (int m = 0; m < 4; ++m) { bf16_t* rowp = O + (size_t)(row0 + ai * 128 + m * 16) * ldc + col0;
#pragma unroll
                for (int bj = 0; bj < 2; ++bj) { f32x4 v0 = acc[ai][bj][m][0], v1 = acc[ai][bj][m][1];
                    if (ACT == 1) { v0 = v0 + bv[bj][0]; v1 = v1 + bv[bj][1];
                        f32x2 a = pg8::gelu_pk((f32x2){v0[0], v0[1]}), b = pg8::gelu_pk((f32x2){v0[2], v0[3]}), c = pg8::gelu_pk((f32x2){v1[0], v1[1]}), d = pg8::gelu_pk((f32x2){v1[2], v1[3]});
                        v0 = (f32x4){a.x, a.y, b.x, b.y}; v1 = (f32x4){c.x, c.y, d.x, d.y}; }
                    if (ACT == 2) {
#pragma unroll
                        for (int j = 0; j < 4; ++j) { const float p0 = fmaxf(v0[j], 0.f), p1 = fmaxf(v1[j], 0.f); v0[j] = p0 * p0; v1[j] = p1 * p1; } }
                    u32x4 w; w.x = cvt_pk_bf16(v0[0], v0[1]); w.y = cvt_pk_bf16(v0[2], v0[3]); w.z = cvt_pk_bf16(v1[0], v1[1]); w.w = cvt_pk_bf16(v1[2], v1[3]);
                    *(u32x4*)(rowp + bj * 128) = w; } }
    }
};
struct EpiQKV {
    static constexpr bool PERM = true, AFTER_DRAIN = false;
    bf16_t* O; const float* rc; const float* rs;
    __device__ __forceinline__ void operator()(const f32x4 (&acc)[2][2][4][2], const Unit& u, int wr, int wc, int fr, int fq) const {
        const int pb = u.pm % 9, kind = u.pn >> 2;
        const bool rope = (pb != 0) && (kind < 2);
        const float sc = (kind == 1) ? 0.0625f : 1.f;
        const int row0 = u.pm * 256 + wr * 64 + fr, col0 = u.pn * 256 + wc * 32 + 8 * fq, i0 = wc * 32 + 8 * fq;
#pragma unroll
        for (int ai = 0; ai < 2; ++ai)
#pragma unroll
            for (int m = 0; m < 4; ++m) {
                bf16_t* rowp = O + (ptrdiff_t)(row0 + ai * 128 + m * 16) * 4096 + col0;
                f32x4 a0 = acc[ai][0][m][0] * sc, a1 = acc[ai][0][m][1] * sc, b0 = acc[ai][1][m][0] * sc, b1 = acc[ai][1][m][1] * sc;
                if (rope) {
                    const int t = (pb - 1) * 256 + ai * 128 + wr * 64 + m * 16 + fr;
                    const f32x4 c0 = *(const f32x4*)(rc + t * 128 + i0), c1 = *(const f32x4*)(rc + t * 128 + i0 + 4);
                    const f32x4 s0 = *(const f32x4*)(rs + t * 128 + i0), s1 = *(const f32x4*)(rs + t * 128 + i0 + 4);
                    const f32x4 o0 = a0 * c0 - b0 * s0, o1 = a1 * c1 - b1 * s1, p0 = a0 * s0 + b0 * c0, p1 = a1 * s1 + b1 * c1;
                    a0 = o0; a1 = o1; b0 = p0; b1 = p1;
                }
                u32x4 w; w.x = cvt_pk_bf16(a0[0], a0[1]); w.y = cvt_pk_bf16(a0[2], a0[3]); w.z = cvt_pk_bf16(a1[0], a1[1]); w.w = cvt_pk_bf16(a1[2], a1[3]);
                *(u32x4*)rowp = w;
                w.x = cvt_pk_bf16(b0[0], b0[1]); w.y = cvt_pk_bf16(b0[2], b0[3]); w.z = cvt_pk_bf16(b1[0], b1[1]); w.w = cvt_pk_bf16(b1[2], b1[3]);
                *(u32x4*)(rowp + 128) = w;
            }
    }
};
struct EpiGate {
    static constexpr bool PERM = true, AFTER_DRAIN = false;
    bf16_t* O; const float* ST;
    __device__ __forceinline__ void operator()(const f32x4 (&acc)[2][2][4][2], const Unit& u, int wr, int wc, int fr, int fq) const {
        const int row0 = u.pm * 256 + wr * 64 + fr, ch0 = u.pn * 128 + wc * 32 + 8 * fq, h = ch0 >> 9;
#pragma unroll
        for (int ai = 0; ai < 2; ++ai)
#pragma unroll
            for (int m = 0; m < 4; ++m) {
                const ptrdiff_t row = row0 + ai * 128 + m * 16;
                const float* sp = ST + (row * 4 + h) * 32;
                float mean[2], rstd[2];
#pragma unroll
                for (int d = 0; d < 2; ++d) {
                    const f32x4 p0 = *(const f32x4*)(sp + d * 16), p1 = *(const f32x4*)(sp + d * 16 + 4), p2 = *(const f32x4*)(sp + d * 16 + 8), p3 = *(const f32x4*)(sp + d * 16 + 12);
                    const float s = (p0[0] + p0[2]) + (p1[0] + p1[2]) + (p2[0] + p2[2]) + (p3[0] + p3[2]);
                    const float q = (p0[1] + p0[3]) + (p1[1] + p1[3]) + (p2[1] + p2[3]) + (p3[1] + p3[3]);
                    const float mu = s * (1.f / 512.f); const float var = fmaxf(q * (1.f / 512.f) - mu * mu, 0.f);
                    mean[d] = mu; rstd[d] = 1.0f / sqrtf(var + LN_EPS);
                }
                bf16_t* op = O + row * 4096 + ch0;
                const u32x4 of = *(const u32x4*)op, ob = *(const u32x4*)(op + 2048);
                float y[8];
#pragma unroll
                for (int e = 0; e < 8; ++e) {
                    const unsigned wf = of[e >> 1], wb = ob[e >> 1];
                    const float vf = (e & 1) ? bfhi(wf) : bflo(wf), vb = (e & 1) ? bfhi(wb) : bflo(wb);
                    const float gf = acc[ai][0][m][e >> 2][e & 3], gb = acc[ai][1][m][e >> 2][e & 3];
                    y[e] = (vf - mean[0]) * rstd[0] * silu_f(gf) + (vb - mean[1]) * rstd[1] * silu_f(gb);
                }
                u32x4 w; w.x = cvt_pk_bf16(y[0], y[1]); w.y = cvt_pk_bf16(y[2], y[3]); w.z = cvt_pk_bf16(y[4], y[5]); w.w = cvt_pk_bf16(y[6], y[7]);
                *(u32x4*)op = w;
            }
    }
};

template <class Epi> __device__ __forceinline__ void run_gemm(LAS unsigned char* lds, const bf16_t* A, int lda, const bf16_t* Bt, int K, int nM, int nN, int pm_off, int skip, const Epi& E) {
    pg8::Gemm g{A, Bt, K, lda, K}; Sched S; S.init(nM, nN, (int)gridDim.x, (int)blockIdx.x, pm_off, skip);
    pg8::gemm_phase<Epi, Sched, true, true>(lds, g, S, E);
}

__device__ __forceinline__ void conv_tile(LAS unsigned char* lds, const float* src, int ld, int col0, int k0, int n0, bf16_t* dst, int Kdst, bool gate, int tid) {
    LAS bf16_t* T = (LAS bf16_t*)lds;
#pragma unroll
    for (int it = 0; it < 2; ++it) {
        const int kk = (tid >> 4) + 32 * it, n4 = (tid & 15) * 4;
        const f32x4 v = *(const f32x4*)(src + (size_t)(k0 + kk) * ld + col0 + n0 + n4);
        const unsigned p01 = cvt_pk_bf16(v[0], v[1]), p23 = cvt_pk_bf16(v[2], v[3]);
        T[(n4 + 0) * 72 + kk] = (bf16_t)(p01 & 0xffffu); T[(n4 + 1) * 72 + kk] = (bf16_t)(p01 >> 16);
        T[(n4 + 2) * 72 + kk] = (bf16_t)(p23 & 0xffffu); T[(n4 + 3) * 72 + kk] = (bf16_t)(p23 >> 16);
    }
    __syncthreads();
    {
        const int n = tid >> 3, kc = (tid & 7) * 8;
        const u32x4 val = *(const LAS u32x4*)(T + n * 72 + kc);
        int nn = n0 + n;
        if (gate) { const int dir = nn >> 11, ch = nn & 2047; nn = (ch >> 7) * 256 + dir * 128 + (ch & 127); }
        *(u32x4*)(dst + (size_t)nn * Kdst + k0 + kc) = val;
    }
    __syncthreads();
}

__device__ __forceinline__ void prologue0(LAS unsigned char* lds) {
    const Params p = kparams();
    int tid = threadIdx.x; asm volatile("" : "+v"(tid));
    unsigned char* ws = p.ws;
    constexpr int N_MOD = 192, N_CONV = 16384, N_WS = 64, N_ROPE = 64, N_ITEMS = N_MOD + N_CONV + N_WS + N_ROPE;
    for (int it = blockIdx.x; it < N_ITEMS; it += gridDim.x) {
        if (it < N_MOD) {
            const int l = it / 48, rem = it - l * 48, cb = rem >> 2, kq = rem & 3, n = cb * 512 + tid;
            LAS float* sct = (LAS float*)lds;
            float acc[36];
            const float b0 = kq == 0 ? p.ada_b[l * 6144 + n] : 0.f;
#pragma unroll
            for (int r = 0; r < 36; ++r) acc[r] = b0;
            for (int idx = tid; idx < 36 * 256; idx += NTHR) {
                const int r = idx >> 8, kk = idx & 255;
                float v = 0.f;
                if (r < 32) v = silu_f(p.c[r * 1024 + kq * 256 + kk]); else if (r == 32) v = silu_f(p.c_ctx[kq * 256 + kk]);
                sct[kk * 36 + r] = v;
            }
            __syncthreads();
            const float* wp = p.ada_w + ((size_t)l * 1024 + kq * 256) * 6144 + n;
            for (int k8 = 0; k8 < 256; k8 += 8) {
                float w[8];
#pragma unroll
                for (int u = 0; u < 8; ++u) w[u] = wp[(size_t)(k8 + u) * 6144];
#pragma unroll
                for (int u = 0; u < 8; ++u)
#pragma unroll
                    for (int r4 = 0; r4 < 9; ++r4) {
                        const f32x4 sv = *(const LAS f32x4*)(sct + (k8 + u) * 36 + r4 * 4);
                        acc[r4 * 4 + 0] += sv[0] * w[u]; acc[r4 * 4 + 1] += sv[1] * w[u]; acc[r4 * 4 + 2] += sv[2] * w[u]; acc[r4 * 4 + 3] += sv[3] * w[u];
                    }
            }
            float* part = (float*)(ws + WS_ST) + (size_t)kq * MODN;
#pragma unroll
            for (int r = 0; r < 33; ++r) part[((size_t)l * 33 + r) * 6144 + n] = acc[r];
            __syncthreads();
        } else if (it < N_MOD + N_CONV) {
            const int T = it - N_MOD;
            const float* src; int ld, col0 = 0, kt, nt, Kdst; bf16_t* dst; bool gate = false;
            if (T < 2048) { const int j = T >> 10, t = T & 1023; kt = t >> 6; nt = t & 63; src = p.a_w_in + (size_t)j * 1024 * 4096; ld = 4096; dst = (bf16_t*)(ws + WS_WA_IN + j * SZ_W4); Kdst = 1024; }
            else if (T < 3072) { const int T2 = T - 2048, j = T2 >> 9, t = T2 & 511; kt = t >> 4; nt = t & 15; src = p.a_w_out + (size_t)j * 2048 * 1024; ld = 1024; dst = (bf16_t*)(ws + WS_WA_OUT + j * (SZ_W4 / 2)); Kdst = 2048; }
            else if (T < 5120) { const int T2 = T - 3072, j = T2 >> 10, t = T2 & 1023; kt = t >> 6; nt = t & 63; src = p.b_w_in + (size_t)j * 1024 * 8192; ld = 8192; dst = (bf16_t*)(ws + WS_WB_QKV + j * SZ_W4); Kdst = 1024; }
            else if (T < 7168) { const int T2 = T - 5120, j = T2 >> 10, t = T2 & 1023; kt = t >> 6; nt = t & 63; src = p.b_w_in + (size_t)j * 1024 * 8192; ld = 8192; col0 = 4096; dst = (bf16_t*)(ws + WS_WB_GATE + j * SZ_W4); Kdst = 1024; gate = true; }
            else if (T < 8192) { const int T2 = T - 7168, j = T2 >> 9, t = T2 & 511; kt = t >> 4; nt = t & 15; src = p.b_w_out + (size_t)j * 2048 * 1024; ld = 1024; dst = (bf16_t*)(ws + WS_WB_OUT + j * (SZ_W4 / 2)); Kdst = 2048; }
            else if (T < 12288) { const int T2 = T - 8192, l = T2 >> 10, t = T2 & 1023; kt = t >> 6; nt = t & 63; src = p.ffn_w1 + (size_t)l * 1024 * 4096; ld = 4096; dst = (bf16_t*)(ws + WS_W1 + l * SZ_W4); Kdst = 1024; }
            else { const int T2 = T - 12288, l = T2 >> 10, t = T2 & 1023; kt = t >> 4; nt = t & 15; src = p.ffn_w2 + (size_t)l * 4096 * 1024; ld = 1024; dst = (bf16_t*)(ws + WS_W2 + l * SZ_W4); Kdst = 4096; }
            conv_tile(lds, src, ld, col0, kt * 64, nt * 64, dst, Kdst, gate, tid);
        } else if (it < N_MOD + N_CONV + N_WS) {
            const int base = (it - N_MOD - N_CONV) * 4096 + tid * 8;
            const f32x4 v0 = *(const f32x4*)(p.a_w_s + base), v1 = *(const f32x4*)(p.a_w_s + base + 4);
            u32x4 w; w.x = cvt_pk_bf16(v0[0], v0[1]); w.y = cvt_pk_bf16(v0[2], v0[3]); w.z = cvt_pk_bf16(v1[0], v1[1]); w.w = cvt_pk_bf16(v1[2], v1[3]);
            *(u32x4*)((bf16_t*)(ws + WS_WS) + base) = w;
        } else {
            float* rc = (float*)(ws + WS_ROPE); float* rs = rc + 2048 * 128;
            const int base = (it - N_MOD - N_CONV - N_WS) * 4096 + tid * 8;
#pragma unroll
            for (int e = 0; e < 8; ++e) {
                const int id = base + e, t = id >> 7, i = id & 127, f = i & 63;
                const float pos = (float)((i < 64) ? (t >> 6) : (t & 63));
                const float inv = __builtin_amdgcn_exp2f(-(float)f * (13.287712379549449f / 64.f));
                const float ang = pos * inv;
                float rev = ang * 0.15915494309189535f; rev -= rintf(rev);
                rc[id] = __builtin_amdgcn_cosf(rev); rs[id] = __builtin_amdgcn_sinf(rev);
            }
        }
    }
}

__device__ __forceinline__ void prologue1() {
    const Params p = kparams();
    int tid = threadIdx.x; asm volatile("" : "+v"(tid));
    const int lane = tid & 63, wid = tid >> 6;
    float* mod = (float*)(p.ws + WS_MOD);
    const float* part = (const float*)(p.ws + WS_ST);
    for (int i = (blockIdx.x * NTHR + tid) * 4; i < MODN; i += gridDim.x * NTHR * 4)
        *(f32x4*)(mod + i) = (*(const f32x4*)(part + i) + *(const f32x4*)(part + MODN + i)) + (*(const f32x4*)(part + 2 * MODN + i) + *(const f32x4*)(part + 3 * MODN + i));
    bf16_t* H = (bf16_t*)(p.ws + WS_H);
    for (int r = blockIdx.x * 8 + wid; r < MT; r += gridDim.x * 8) {
        const int b = r / RPB, j = r - b * RPB; const bool isctx = j < 256;
        const float* xs = isctx ? p.ctx + ((size_t)b * 256 + j) * 1024 : p.x + ((size_t)b * 2048 + (j - 256)) * 1024;
        const float* mr = part + (size_t)(isctx ? 32 : b) * 6144;
#pragma unroll
        for (int q = 0; q < 4; ++q) {
            const int col = q * 256 + lane * 4;
            const f32x4 xv = *(const f32x4*)(xs + col);
            const f32x4 sh = (*(const f32x4*)(mr + col) + *(const f32x4*)(mr + MODN + col)) + (*(const f32x4*)(mr + 2 * MODN + col) + *(const f32x4*)(mr + 3 * MODN + col));
            const f32x4 sc = (*(const f32x4*)(mr + 1024 + col) + *(const f32x4*)(mr + MODN + 1024 + col)) + (*(const f32x4*)(mr + 2 * MODN + 1024 + col) + *(const f32x4*)(mr + 3 * MODN + 1024 + col));
            const f32x4 h = xv * (sc + 1.0f) + sh;
            *(u32x2*)(H + (size_t)r * 1024 + col) = pack4(h);
        }
    }
}

__device__ __forceinline__ void ln_phase(int l, int which, bool last) {
    const Params p = kparams();
    const float* xl_src = (l == 0 && which == 0) ? p.x : p.out; const float* xc_src = (l == 0 && which == 0) ? p.ctx : (const float*)(p.ws + WS_CX);
    const int gate_off = which ? 5120 : 2048; const float* lng = (which ? p.ln2_g : p.ln1_g) + l * 1024; const float* lnb = (which ? p.ln2_b : p.ln1_b) + l * 1024;
    const int l_next = which ? (last ? l : l + 1) : l, sh_off = which ? 0 : 3072, sc_off = which ? 1024 : 4096; const bool write_h = which ? !last : true, skipctx = last;
    int tid = threadIdx.x; asm volatile("" : "+v"(tid));
    const int lane = tid & 63, wid = tid >> 6;
    const float* mod = (const float*)(p.ws + WS_MOD);
    bf16_t* H = (bf16_t*)(p.ws + WS_H);
    float* CX = (float*)(p.ws + WS_CX);
    const int nw = gridDim.x * 8;
    for (int rb = blockIdx.x * 8 + wid; rb < MT; rb += 2 * nw) {
        const float* xs[2]; float* xd[2]; int mrow[2]; bool act[2]; size_t hoff[2];
        f32x4 t[2][4]; float s[2];
#pragma unroll
        for (int k = 0; k < 2; ++k) {
            const int r = rb + k * nw; const int rr = r < MT ? r : rb;
            const int b = rr / RPB, j = rr - b * RPB; const bool isctx = j < 256;
            act[k] = (r < MT) && !(isctx && skipctx);
            const size_t xo = isctx ? ((size_t)b * 256 + j) * 1024 : ((size_t)b * 2048 + (j - 256)) * 1024;
            xs[k] = (isctx ? xc_src : xl_src) + xo; xd[k] = (isctx ? CX : p.out) + xo; mrow[k] = isctx ? 32 : b; hoff[k] = (size_t)rr * 1024;
            const float* gate = mod + ((size_t)l * 33 + mrow[k]) * 6144 + gate_off;
            s[k] = 0.f;
#pragma unroll
            for (int q = 0; q < 4; ++q) {
                const int col = q * 256 + lane * 4;
                const f32x4 xv = *(const f32x4*)(xs[k] + col), gv = *(const f32x4*)(gate + col);
                const u32x2 yw = *(const u32x2*)(H + hoff[k] + col);
                const f32x4 yv = {bflo(yw.x), bfhi(yw.x), bflo(yw.y), bfhi(yw.y)};
                t[k][q] = xv * DN_ALPHA + gv * yv;
                s[k] += (t[k][q][0] + t[k][q][1]) + (t[k][q][2] + t[k][q][3]);
            }
        }
#pragma unroll
        for (int k = 0; k < 2; ++k) {
            const float mean = wave_sum(s[k]) * (1.f / 1024.f);
            float v = 0.f;
#pragma unroll
            for (int q = 0; q < 4; ++q) { const f32x4 d = t[k][q] - mean; v += (d[0] * d[0] + d[1] * d[1]) + (d[2] * d[2] + d[3] * d[3]); }
            const float rstd = 1.0f / sqrtf(wave_sum(v) * (1.f / 1024.f) + LN_EPS);
            const float* shp = mod + ((size_t)l_next * 33 + mrow[k]) * 6144 + sh_off;
            const float* scp = mod + ((size_t)l_next * 33 + mrow[k]) * 6144 + sc_off;
            if (act[k]) {
#pragma unroll
                for (int q = 0; q < 4; ++q) {
                    const int col = q * 256 + lane * 4;
                    const f32x4 g4 = *(const f32x4*)(lng + col), b4 = *(const f32x4*)(lnb + col);
                    const f32x4 xn = (t[k][q] - mean) * rstd * g4 + b4;
                    *(f32x4*)(xd[k] + col) = xn;
                    if (write_h) {
                        const f32x4 sh = *(const f32x4*)(shp + col), sc = *(const f32x4*)(scp + col);
                        *(u32x2*)(H + hoff[k] + col) = pack4(xn * (sc + 1.0f) + sh);
                    }
                }
            }
        }
    }
}

__device__ __forceinline__ void gating_phase(LAS unsigned char* lds, int jl) {
    const Params p = kparams();
    int tid_ = threadIdx.x; asm volatile("" : "+v"(tid_));
    const int tid = tid_, lane = tid & 63, wid = tid >> 6, fr = lane & 15, fq = lane >> 4;
    bf16_t* Z = (bf16_t*)(p.ws + WS_Z);
    const bf16_t* Wsb = (const bf16_t*)(p.ws + WS_WS) + (size_t)jl * 8 * 128 * 128;
    const float* lng = p.a_ln_g + jl * 2048; const float* lnb = p.a_ln_b + jl * 2048; const float* bs = p.a_b_s + jl * 8 * 128;
    LAS unsigned char* VN = lds;
    LAS unsigned char* WSI = lds + 67584;
    LAS float* STAT = (LAS float*)(lds + 102400);
    const int wc2 = wid & 3, wi2 = wid >> 2;
    for (int ci = blockIdx.x; ci < MT / 128; ci += gridDim.x) {
        const size_t row0 = (size_t)ci * 128;
        for (int tt = 0; tt < 16; ++tt) {
            const int j = wid * 16 + tt;
            const bf16_t* vp = Z + (row0 + j) * 4096 + 2048 + lane * 8;
            u32x4 raw[4]; float s = 0.f;
#pragma unroll
            for (int q = 0; q < 4; ++q) { raw[q] = *(const u32x4*)(vp + q * 512);
#pragma unroll
                for (int e = 0; e < 4; ++e) s += bflo(raw[q][e]) + bfhi(raw[q][e]); }
            const float mean = wave_sum(s) * (1.f / 2048.f);
            float v = 0.f;
#pragma unroll
            for (int q = 0; q < 4; ++q)
#pragma unroll
                for (int e = 0; e < 4; ++e) { const float d0 = bflo(raw[q][e]) - mean, d1 = bfhi(raw[q][e]) - mean; v += d0 * d0 + d1 * d1; }
            const float rstd = 1.0f / sqrtf(wave_sum(v) * (1.f / 2048.f) + LN_EPS);
            if (lane == 0) { STAT[j * 2] = mean; STAT[j * 2 + 1] = rstd; }
        }
        __syncthreads();
        for (int g = 0; g < 8; ++g) {
#pragma unroll
            for (int x = 0; x < 8; ++x) {
                const int q = tid + 512 * x, j = q >> 5, cc = (q & 31) * 8;
                const u32x4 raw = *(const u32x4*)(Z + (row0 + j) * 4096 + 2048 + g * 256 + cc);
                const float mean = STAT[j * 2], rstd = STAT[j * 2 + 1];
                const f32x4 g0 = *(const f32x4*)(lng + g * 256 + cc), g1 = *(const f32x4*)(lng + g * 256 + cc + 4), b0 = *(const f32x4*)(lnb + g * 256 + cc), b1 = *(const f32x4*)(lnb + g * 256 + cc + 4);
                u32x4 w;
                w.x = cvt_pk_bf16((bflo(raw.x) - mean) * rstd * g0[0] + b0[0], (bfhi(raw.x) - mean) * rstd * g0[1] + b0[1]);
                w.y = cvt_pk_bf16((bflo(raw.y) - mean) * rstd * g0[2] + b0[2], (bfhi(raw.y) - mean) * rstd * g0[3] + b0[3]);
                w.z = cvt_pk_bf16((bflo(raw.z) - mean) * rstd * g1[0] + b1[0], (bfhi(raw.z) - mean) * rstd * g1[1] + b1[1]);
                w.w = cvt_pk_bf16((bflo(raw.w) - mean) * rstd * g1[2] + b1[2], (bfhi(raw.w) - mean) * rstd * g1[3] + b1[3]);
                *(LAS u32x4*)(VN + j * 528 + cc * 2) = w;
            }
#pragma unroll
            for (int x = 0; x < 4; ++x) {
                const int q = tid + 512 * x, i = q >> 4, jc = (q & 15) * 8;
                *(LAS u32x4*)(WSI + i * 272 + jc * 2) = *(const u32x4*)(Wsb + (size_t)g * 16384 + i * 128 + jc);
            }
            __syncthreads();
            f32x4 acc[4][4];
#pragma unroll
            for (int a = 0; a < 4; ++a)
#pragma unroll
                for (int b = 0; b < 4; ++b) acc[a][b] = (f32x4){0.f, 0.f, 0.f, 0.f};
#pragma unroll
            for (int ks = 0; ks < 4; ++ks) {
                bf16x8 af[4], bf[4];
#pragma unroll
                for (int ct = 0; ct < 4; ++ct) af[ct] = frag_tr(VN, 528, ks * 32, (4 * wc2 + ct) * 16, lane);
#pragma unroll
                for (int it = 0; it < 4; ++it) bf[it] = frag_row(WSI, 272, (4 * wi2 + it) * 16, ks * 32, lane);
#pragma unroll
                for (int ct = 0; ct < 4; ++ct)
#pragma unroll
                    for (int it = 0; it < 4; ++it) acc[ct][it] = mfma16(af[ct], bf[it], acc[ct][it]);
            }
#pragma unroll
            for (int it = 0; it < 4; ++it) {
                const int i = (4 * wi2 + it) * 16 + fr; const float bsv = bs[g * 128 + i];
#pragma unroll
                for (int ct = 0; ct < 4; ++ct) {
                    bf16_t* up = Z + (row0 + i) * 4096 + g * 256 + (4 * wc2 + ct) * 16 + 4 * fq;
                    const u32x2 uu = *(const u32x2*)up;
                    const f32x4 sv = acc[ct][it] + bsv;
                    const f32x4 o = {bflo(uu.x) * sv[0], bfhi(uu.x) * sv[1], bflo(uu.y) * sv[2], bfhi(uu.y) * sv[3]};
                    *(u32x2*)up = pack4(o);
                }
            }
            __syncthreads();
        }
    }
}

__device__ __forceinline__ void retention_phase(LAS unsigned char* lds, int jl) {
    const Params p = kparams();
    const bf16_t* QKV = (const bf16_t*)(p.ws + WS_Z);
    bf16_t* O = (bf16_t*)(p.ws + WS_Z) + (size_t)HROWS * 4096;
    float* ST = (float*)(p.ws + WS_ST);
    LAS unsigned char* QH = lds;
    LAS unsigned char* KH = lds + 34816;
    LAS unsigned char* SH = lds + 69632;
    LAS unsigned char* VZ = lds + 104448;
    for (int idx = blockIdx.x; idx < 512; idx += gridDim.x) {
        const int es = idx & 3, dir = (idx >> 2) & 1, h = (idx >> 3) & 3, bl = idx >> 5;
        const float lg = log1pf(-__expf(p.b_decay[(jl * 2 + dir) * 4 + h]));
        const float gc = __expf(lg * 128.f);
        f32x4 accS[2][2][4];
#pragma unroll
        for (int a = 0; a < 2; ++a)
#pragma unroll
            for (int b = 0; b < 2; ++b)
#pragma unroll
                for (int c = 0; c < 4; ++c) accS[a][b][c] = (f32x4){0.f, 0.f, 0.f, 0.f};
        for (int step = 0; step < 18; ++step) {
            int tid_ = threadIdx.x; asm volatile("" : "+v"(tid_));
            const int tid = tid_, lane = tid & 63, wid = __builtin_amdgcn_readfirstlane(tid >> 6), fr = lane & 15, fq = lane >> 4;
            const int wlo = wid & 3, whi = wid >> 2;
            const int n = dir == 0 ? step : (step < 2 ? 1 - step : 19 - step);
            const size_t row0 = (size_t)bl * RPB + n * 128;
            f32x4 accP[4][2], accO[4][2];
#pragma unroll
            for (int a = 0; a < 4; ++a)
#pragma unroll
                for (int b = 0; b < 2; ++b) { accP[a][b] = (f32x4){0.f, 0.f, 0.f, 0.f}; accO[a][b] = (f32x4){0.f, 0.f, 0.f, 0.f}; }
#pragma unroll
            for (int x = 0; x < 4; ++x) {
                const int q = tid + 512 * x, j = q >> 4, ec = (q & 15) * 8;
                const u32x4 raw = *(const u32x4*)(QKV + (row0 + j) * 4096 + 2048 + h * 512 + es * 128 + ec);
                const float z = __expf(lg * (float)(dir ? j : 127 - j));
                u32x4 w;
                w.x = cvt_pk_bf16(bflo(raw.x) * z, bfhi(raw.x) * z); w.y = cvt_pk_bf16(bflo(raw.y) * z, bfhi(raw.y) * z);
                w.z = cvt_pk_bf16(bflo(raw.z) * z, bfhi(raw.z) * z); w.w = cvt_pk_bf16(bflo(raw.w) * z, bfhi(raw.w) * z);
                *(LAS u32x4*)(VZ + j * 272 + ec * 2) = w;
            }
#pragma unroll
            for (int dh = 0; dh < 2; ++dh) {
                {
                    const int i = tid >> 4, dc = (tid & 15) * 8;
                    const bf16_t* rp = QKV + (row0 + i) * 4096 + h * 256 + dh * 128 + dc;
                    LAS unsigned char* lq = QH + i * 272 + dc * 2;
                    u32x4 t0 = *(const u32x4*)rp, t1 = *(const u32x4*)(rp + 32 * 4096), t2 = *(const u32x4*)(rp + 64 * 4096), t3 = *(const u32x4*)(rp + 96 * 4096);
                    *(LAS u32x4*)lq = t0; *(LAS u32x4*)(lq + 32 * 272) = t1; *(LAS u32x4*)(lq + 64 * 272) = t2; *(LAS u32x4*)(lq + 96 * 272) = t3;
                    __builtin_amdgcn_sched_barrier(0);
                    t0 = *(const u32x4*)(rp + 1024); t1 = *(const u32x4*)(rp + 1024 + 32 * 4096); t2 = *(const u32x4*)(rp + 1024 + 64 * 4096); t3 = *(const u32x4*)(rp + 1024 + 96 * 4096);
                    *(LAS u32x4*)(lq + 34816) = t0; *(LAS u32x4*)(lq + 34816 + 32 * 272) = t1; *(LAS u32x4*)(lq + 34816 + 64 * 272) = t2; *(LAS u32x4*)(lq + 34816 + 96 * 272) = t3;
                    __builtin_amdgcn_sched_barrier(0);
                }
#pragma unroll
                for (int dt = 0; dt < 2; ++dt)
#pragma unroll
                    for (int et = 0; et < 4; ++et)
                        *(LAS u32x2*)(SH + ((4 * whi + et) * 16 + fr) * 272 + ((2 * wlo + dt) * 16 + 4 * fq) * 2) = pack4(accS[dh][dt][et]);
                __syncthreads();
#pragma unroll
                for (int ks = 0; ks < 4; ++ks) {
                    bf16x8 qf[2], kf[4];
#pragma unroll
                    for (int it = 0; it < 2; ++it) qf[it] = frag_row(QH, 272, (2 * wlo + it) * 16, ks * 32, lane);
#pragma unroll
                    for (int jt = 0; jt < 4; ++jt) kf[jt] = frag_row(KH, 272, (4 * whi + jt) * 16, ks * 32, lane);
#pragma unroll
                    for (int jt = 0; jt < 4; ++jt)
#pragma unroll
                        for (int it = 0; it < 2; ++it) accP[jt][it] = mfma16(kf[jt], qf[it], accP[jt][it]);
                    __builtin_amdgcn_sched_barrier(0);
                }
#pragma unroll
                for (int ks = 0; ks < 4; ++ks) {
                    bf16x8 qf[2], sf[4];
#pragma unroll
                    for (int it = 0; it < 2; ++it) qf[it] = frag_row(QH, 272, (2 * wlo + it) * 16, ks * 32, lane);
#pragma unroll
                    for (int et = 0; et < 4; ++et) sf[et] = frag_row(SH, 272, (4 * whi + et) * 16, ks * 32, lane);
#pragma unroll
                    for (int et = 0; et < 4; ++et)
#pragma unroll
                        for (int it = 0; it < 2; ++it) accO[et][it] = mfma16(sf[et], qf[it], accO[et][it]);
                    __builtin_amdgcn_sched_barrier(0);
                }
#pragma unroll
                for (int dt = 0; dt < 2; ++dt)
#pragma unroll
                    for (int et = 0; et < 4; ++et) accS[dh][dt][et] = accS[dh][dt][et] * gc;
#pragma unroll
                for (int ks = 0; ks < 4; ++ks) {
                    bf16x8 kt[2], vt[4];
#pragma unroll
                    for (int dt = 0; dt < 2; ++dt) kt[dt] = frag_tr(KH, 272, ks * 32, (2 * wlo + dt) * 16, lane);
#pragma unroll
                    for (int et = 0; et < 4; ++et) vt[et] = frag_tr(VZ, 272, ks * 32, (4 * whi + et) * 16, lane);
#pragma unroll
                    for (int dt = 0; dt < 2; ++dt)
#pragma unroll
                        for (int et = 0; et < 4; ++et) accS[dh][dt][et] = mfma16(kt[dt], vt[et], accS[dh][dt][et]);
                    __builtin_amdgcn_sched_barrier(0);
                }
                __syncthreads();
            }
#pragma unroll
            for (int it = 0; it < 2; ++it) {
                const int i = (2 * wlo + it) * 16 + fr;
                const float xi = __expf(lg * (float)(dir ? 128 - i : i + 1));
                const float mk = __expf(lg * (float)(dir ? -i : i - 127));
#pragma unroll
                for (int et = 0; et < 4; ++et) accO[et][it] = accO[et][it] * xi;
#pragma unroll
                for (int jt = 0; jt < 4; ++jt) {
                    const int j0 = (4 * whi + jt) * 16 + 4 * fq;
                    f32x4 pv; const int d0 = dir ? (j0 - i) : (i - j0), ds = dir ? 1 : -1;
#pragma unroll
                    for (int r = 0; r < 4; ++r) { const float mr = fminf(fmaxf((float)(d0 + r * ds + 1), 0.f), 1.f); pv[r] = accP[jt][it][r] * (mk * mr); }
                    *(LAS u32x2*)(QH + i * 272 + j0 * 2) = pack4(pv);
                }
            }
            __syncthreads();
#pragma unroll
            for (int ks = 0; ks < 4; ++ks) {
                bf16x8 pf[2], vt[4];
#pragma unroll
                for (int it = 0; it < 2; ++it) pf[it] = frag_row(QH, 272, (2 * wlo + it) * 16, ks * 32, lane);
#pragma unroll
                for (int et = 0; et < 4; ++et) vt[et] = frag_tr(VZ, 272, ks * 32, (4 * whi + et) * 16, lane);
#pragma unroll
                for (int et = 0; et < 4; ++et)
#pragma unroll
                    for (int it = 0; it < 2; ++it) accO[et][it] = mfma16(vt[et], pf[it], accO[et][it]);
                __builtin_amdgcn_sched_barrier(0);
            }
#pragma unroll
            for (int it = 0; it < 2; ++it) {
                const size_t row = row0 + (2 * wlo + it) * 16 + fr;
                float s = 0.f, q2 = 0.f;
#pragma unroll
                for (int et = 0; et < 4; ++et) {
                    const f32x4 v = accO[et][it];
                    s += (v[0] + v[1]) + (v[2] + v[3]); q2 += (v[0] * v[0] + v[1] * v[1]) + (v[2] * v[2] + v[3] * v[3]);
                    *(u32x2*)(O + row * 4096 + dir * 2048 + h * 512 + es * 128 + (4 * whi + et) * 16 + 4 * fq) = pack4(v);
                }
                s += __shfl_xor(s, 16); s += __shfl_xor(s, 32); q2 += __shfl_xor(q2, 16); q2 += __shfl_xor(q2, 32);
                if (fq == 0) *(f32x2*)(ST + ((row * 4 + h) * 2 + dir) * 16 + (es * 2 + whi) * 2) = (f32x2){s, q2};
            }
            __syncthreads();
        }
    }
}

__device__ __forceinline__ void gemm_a_in(LAS unsigned char* lds, int jl) {
    const Params p = kparams(); unsigned char* ws = p.ws;
    EpiAct<1> E{(bf16_t*)(ws + WS_Z), 4096, p.a_b_in + jl * 4096};
    run_gemm(lds, (const bf16_t*)(ws + WS_H), 1024, (const bf16_t*)(ws + WS_WA_IN + jl * SZ_W4), 1024, MT / 256, 16, 0, 0, E);
}
__device__ __forceinline__ void gemm_out(LAS unsigned char* lds, size_t w_off, int K, int hb, int mode) {
    const Params p = kparams(); unsigned char* ws = p.ws;
    EpiAct<0> E{(bf16_t*)(ws + WS_H), 1024, nullptr};
    const bf16_t* Z = (const bf16_t*)(ws + WS_Z);
    const bf16_t* A = (mode == 1 || mode == 2) ? Z + (ptrdiff_t)HROWS * 4096 - (ptrdiff_t)hb * HROWS * 4096 : Z;
    const int nM = mode == 0 ? 288 : mode == 1 ? 144 : mode == 2 ? 128 : 256;
    run_gemm(lds, A, 4096, (const bf16_t*)(ws + w_off), K, nM, 4, (mode == 1 || mode == 2) ? hb * 144 : 0, mode >= 2 ? 1 : 0, E);
}
__device__ __forceinline__ void gemm_qkv(LAS unsigned char* lds, int jl, int hb) {
    const Params p = kparams(); unsigned char* ws = p.ws;
    const float* rc = (const float*)(ws + WS_ROPE);
    EpiQKV E{(bf16_t*)(ws + WS_Z) - (ptrdiff_t)hb * HROWS * 4096, rc, rc + 2048 * 128};
    run_gemm(lds, (const bf16_t*)(ws + WS_H), 1024, (const bf16_t*)(ws + WS_WB_QKV + jl * SZ_W4), 1024, 144, 16, hb * 144, 0, E);
}
__device__ __forceinline__ void gemm_gate(LAS unsigned char* lds, int jl, int hb, bool last) {
    const Params p = kparams(); unsigned char* ws = p.ws;
    EpiGate E{(bf16_t*)(ws + WS_Z) + (ptrdiff_t)HROWS * 4096 - (ptrdiff_t)hb * HROWS * 4096, (const float*)(ws + WS_ST) - (ptrdiff_t)hb * HROWS * 128};
    run_gemm(lds, (const bf16_t*)(ws + WS_H), 1024, (const bf16_t*)(ws + WS_WB_GATE + jl * SZ_W4), 1024, last ? 128 : 144, 16, hb * 144, last ? 1 : 0, E);
}
__device__ __forceinline__ void gemm_w1(LAS unsigned char* lds, int l, bool last) {
    const Params p = kparams(); unsigned char* ws = p.ws;
    EpiAct<2> E{(bf16_t*)(ws + WS_Z), 4096, nullptr};
    run_gemm(lds, (const bf16_t*)(ws + WS_H), 1024, (const bf16_t*)(ws + WS_W1 + l * SZ_W4), 1024, last ? 256 : 288, 16, 0, last ? 1 : 0, E);
}

#ifndef REP_SYNC
#define REP_SYNC 1
#endif
#ifndef REP_RET
#define REP_RET 1
#endif
#ifndef REP_GEMM
#define REP_GEMM 1
#endif
#ifndef REP_PRO
#define REP_PRO 1
#endif
#define GSYNC() do { for (int s_ = 0; s_ < REP_SYNC; ++s_) xcd_barrier(xbar); } while (0)
#define REPG(stmt) do { for (int r_ = 0; r_ < REP_GEMM; ++r_) { stmt; } } while (0)
__global__ void __launch_bounds__(NTHR, 2) fwd_kernel(Params pdummy) {
    extern __shared__ __attribute__((aligned(16))) unsigned char smem[];
    LAS unsigned char* lds = (LAS unsigned char*)smem;
    cg::grid_group grid = cg::this_grid();
    volatile LAS unsigned* bst = (volatile LAS unsigned*)(lds + LDS_BYTES - 16);
    unsigned* barw;
    { const Params p0 = kparams(); barw = (unsigned*)(p0.ws + WS_BAR);
      if (threadIdx.x < 4) bst[threadIdx.x] = 0u;
      if (blockIdx.x == 0) for (int i = threadIdx.x; i < XCD_BAR_WORDS; i += NTHR) barw[i] = 0u; }
    for (int r_ = 0; r_ < REP_PRO; ++r_) prologue0(lds);
    grid.sync();
    const XcdBarrier xbar = xcd_barrier_post(barw, bst);
    for (int r_ = 0; r_ < REP_PRO; ++r_) prologue1();
    GSYNC();
#pragma unroll 1
    for (int l = 0; l < 4; ++l) {
        const int jl = l >> 1; const bool last = (l == 3);
        if ((l & 1) == 0) {
            REPG(gemm_a_in(lds, jl));
            GSYNC();
            gating_phase(lds, jl);
            GSYNC();
            REPG(gemm_out(lds, WS_WA_OUT + jl * (SZ_W4 / 2), 2048, 0, 0));
            GSYNC();
        } else {
#pragma unroll 1
            for (int hb = 0; hb < 2; ++hb) {
                REPG(gemm_qkv(lds, jl, hb));
                GSYNC();
                for (int r_ = 0; r_ < REP_RET; ++r_) retention_phase(lds, jl);
                GSYNC();
                gemm_gate(lds, jl, hb, last);
                GSYNC();
                REPG(gemm_out(lds, WS_WB_OUT + jl * (SZ_W4 / 2), 2048, hb, last ? 2 : 1));
                GSYNC();
            }
        }
        ln_phase(l, 0, last);
        GSYNC();
        REPG(gemm_w1(lds, l, last));
        GSYNC();
        REPG(gemm_out(lds, WS_W2 + l * SZ_W4, 4096, 0, last ? 3 : 0));
        GSYNC();
        ln_phase(l, 1, last);
        if (!last) GSYNC();
    }
}

extern "C" void kernel_launch(void* const* d_in, const int* in_sizes, int n_in, void* d_out, int out_size, void* d_ws, size_t ws_size, hipStream_t stream) {
    static int grid = 0;
    if (grid == 0) {
        if (n_in != 22 || ws_size < WS_END) { fprintf(stderr, "kernel_launch: need 22 inputs and %zu bytes of workspace (got %d, %zu)\n", (size_t)WS_END, n_in, ws_size); grid = -1; return; }
        int dev = 0, cus = 0, per_cu = 0;
        (void)hipGetDevice(&dev); (void)hipDeviceGetAttribute(&cus, hipDeviceAttributeMultiprocessorCount, dev);
        if (hipFuncSetAttribute((const void*)fwd_kernel, hipFuncAttributeMaxDynamicSharedMemorySize, LDS_BYTES) != hipSuccess) fprintf(stderr, "kernel_launch: hipFuncSetAttribute failed\n");
        if (hipOccupancyMaxActiveBlocksPerMultiprocessor(&per_cu, (const void*)fwd_kernel, NTHR, LDS_BYTES) != hipSuccess || per_cu < 1) fprintf(stderr, "kernel_launch: occupancy query says %d blocks per CU\n", per_cu);
        (void)hipGetLastError();
        grid = cus > 0 ? cus : 256;
    }
    if (grid < 0) return;
    Params p{};
    const float** pp = (const float**)&p;
    for (int i = 0; i < 22; ++i) pp[i] = (const float*)d_in[i];
    p.out = (float*)d_out; p.ws = (unsigned char*)d_ws;
    void* args[] = {&p};
    const hipError_t e = hipLaunchCooperativeKernel((const void*)fwd_kernel, dim3(grid), dim3(NTHR), args, LDS_BYTES, stream);
    if (e != hipSuccess) fprintf(stderr, "kernel_launch: cooperative launch failed: %s (grid %d)\n", hipGetErrorString(e), grid);
}
```

```cpp
#include <hip/hip_runtime.h>
#include <hip/hip_cooperative_groups.h>
#include <cstdio>
#include <cstdint>
#include <cstddef>
namespace pg8 {
#define PG8_LAS __attribute__((address_space(3)))
typedef unsigned short bf16_t;
typedef short bf16x8 __attribute__((ext_vector_type(8)));
typedef float f32x4 __attribute__((ext_vector_type(4)));
typedef unsigned u32x4 __attribute__((ext_vector_type(4)));
constexpr int BM = 256, BK = 64, HALF = 128, HTB = HALF * BK * 2  , STAGE_BYTES = 8 * HTB, NXCD = 8, WGM = 8;

__host__ __device__ __forceinline__ int lds_byte(int r, int c) { const int st = (r >> 4) * 2 + (c >> 5), rr = r & 15, cc = c & 31, ob = rr * 64 + cc * 2; return st * 1024 + (ob ^ (((ob >> 9) & 1) << 5)); }
__host__ __device__ __forceinline__ void stage_rc(int b, int& R, int& C) { const int st = b / 1024, sb = b % 1024, swz = sb ^ (((sb >> 9) & 1) << 5); R = (st >> 1) * 16 + swz / 64; C = (st & 1) * 32 + (swz % 64) / 2; }
__host__ __device__ __forceinline__ int perm32(int rho) { const int n = rho >> 4, i = rho & 15; return 8 * (i >> 2) + 4 * n + (i & 3); }

struct Unit { int pm, pn; };
struct Gemm { const bf16_t* A; const bf16_t* Bt; int K, lda, ldb; };


__device__ __forceinline__ unsigned cvt_pk_bf16(float lo, float hi) { unsigned r; asm volatile("v_cvt_pk_bf16_f32 %0, %1, %2" : "=v"(r) : "v"(lo), "v"(hi)); return r; }
typedef float f32x2 __attribute__((ext_vector_type(2)));
__device__ __forceinline__ f32x2 gelu_pk(f32x2 v) {
    const f32x2 av = __builtin_elementwise_abs(v), d = av * 0.2316418882f + 1.0f;
    f32x2 t; t.x = __builtin_amdgcn_rcpf(d.x); t.y = __builtin_amdgcn_rcpf(d.y);
    f32x2 q = t * 0.5307027145f + (-0.7265760135f); q = q * t + 0.7107068705f; q = q * t + (-0.142248368f); q = q * t + 0.127414796f; q = q * t;
    const f32x2 s = (v * v) * (-0.72134752044f);
    f32x2 e; e.x = __builtin_amdgcn_exp2f(s.x); e.y = __builtin_amdgcn_exp2f(s.y);
    const f32x2 m = v * (q * e), r = v - m;
    f32x2 o; o.x = v.x < 0.f ? m.x : r.x; o.y = v.y < 0.f ? m.y : r.y; return o;
}


template <class Epi, class Sched, bool ALIGN_EPI = false, bool SP2 = false>
__device__ __forceinline__ void gemm_phase(PG8_LAS unsigned char* lds, const Gemm g, const Sched& S, const Epi& E) {
    int tid_ = threadIdx.x; asm volatile("" : "+v"(tid_));
    const int tid = tid_, wid = __builtin_amdgcn_readfirstlane(tid >> 6), lane = tid & 63, wr = wid >> 2, wc = wid & 3, fr = lane & 15, fq = lane >> 4;
    const int K = g.K, nt = K / BK;
    unsigned voffA[2], voffB[2];
#pragma unroll
    for (int i = 0; i < 2; ++i) { int R, C; stage_rc(tid * 16 + i * 8192, R, C); const int Rb = Epi::PERM ? ((R & ~31) + perm32(R & 31)) : R;
        voffA[i] = (unsigned)(R * g.lda + C) * 2u; voffB[i] = (unsigned)(Rb * g.ldb + C) * 2u; }
    const size_t kstep = (size_t)(BK * 2);
    const size_t hstepA = (size_t)HALF * g.lda * 2, hstepB = (size_t)HALF * g.ldb * 2;
    const size_t tstepA = 2 * hstepA, tstepB = 2 * hstepB;
    const unsigned ldsw = (unsigned)wid * 1024u;
    const int aoff = lds_byte(wr * 64 + fr, fq * 8), boff = lds_byte(wc * 32 + fr, fq * 8);
#define PG8_SA(b, h) (((b) * 2 + (h)) * HTB)
#define PG8_SB(b, h) ((4 + (b) * 2 + (h)) * HTB)
#define PG8_STAGE(bufoff, gbase, voff) do { _Pragma("unroll") for (int _i = 0; _i < 2; ++_i) \
        __builtin_amdgcn_global_load_lds((const unsigned*)((const char*)(gbase) + (voff)[_i]), (PG8_LAS unsigned*)(lds + (bufoff) + ldsw + _i * 8192), 16, 0, 0); } while (0)
#define PG8_LDA(dst, b, h) do { _Pragma("unroll") for (int m = 0; m < 4; ++m) _Pragma("unroll") for (int k = 0; k < 2; ++k) dst[m][k] = *(const PG8_LAS bf16x8*)(lds + PG8_SA(b, h) + aoff + m * 2048 + k * 1024); } while (0)
#define PG8_LDB(dst, b, h) do { _Pragma("unroll") for (int n = 0; n < 2; ++n) _Pragma("unroll") for (int k = 0; k < 2; ++k) dst[n][k] = *(const PG8_LAS bf16x8*)(lds + PG8_SB(b, h) + boff + n * 2048 + k * 1024); } while (0)
#define PG8_MMA(ai, bj, At, Bt) do { __builtin_amdgcn_s_setprio(1); _Pragma("unroll") for (int m = 0; m < 4; ++m) _Pragma("unroll") for (int n = 0; n < 2; ++n) _Pragma("unroll") for (int k = 0; k < 2; ++k) \
        acc[ai][bj][m][n] = __builtin_amdgcn_mfma_f32_16x16x32_bf16(Bt[n][k], At[m][k], acc[ai][bj][m][n], 0, 0, 0); __builtin_amdgcn_s_setprio(0); } while (0)
#define PG8_WAIT_V(n) asm volatile("s_waitcnt vmcnt(" #n ")" ::: "memory")
#define PG8_WAIT_L(n) asm volatile("s_waitcnt lgkmcnt(" #n ")" ::: "memory")
#define PG8_BAR __builtin_amdgcn_s_barrier()
#define PG8_SCHED __builtin_amdgcn_sched_barrier(0)
    Unit cur, nxt; int ui = 0;
    if (!S.next(0, cur)) return;
    f32x4 acc[2][2][4][2];
#pragma unroll
    for (int a = 0; a < 2; ++a)
#pragma unroll
        for (int b = 0; b < 2; ++b)
#pragma unroll
            for (int m = 0; m < 4; ++m)
#pragma unroll
                for (int n = 0; n < 2; ++n) acc[a][b][m][n] = (f32x4){0.f, 0.f, 0.f, 0.f};
    bf16x8 At[4][2], B0[2][2], B1[2][2];
    const char* cA = (const char*)g.A + (size_t)cur.pm * tstepA; const char* cB = (const char*)g.Bt + (size_t)cur.pn * tstepB;
    S.a_ready(cur);
    if constexpr (SP2) {
        PG8_STAGE(PG8_SB(0, 0), cB, voffB); PG8_STAGE(PG8_SB(0, 1), cB + hstepB, voffB); PG8_STAGE(PG8_SA(0, 0), cA, voffA); PG8_STAGE(PG8_SA(0, 1), cA + hstepA, voffA);
        if (wr == 1) PG8_BAR;
        PG8_WAIT_V(2); PG8_BAR;
        PG8_STAGE(PG8_SB(1, 0), cB + kstep, voffB); PG8_STAGE(PG8_SA(1, 0), cA + kstep, voffA); PG8_STAGE(PG8_SB(1, 1), cB + hstepB + kstep, voffB);
        PG8_WAIT_V(6); PG8_BAR;
    } else {
        PG8_STAGE(PG8_SB(0, 0), cB, voffB); PG8_STAGE(PG8_SA(0, 0), cA, voffA); PG8_STAGE(PG8_SB(0, 1), cB + hstepB, voffB); PG8_STAGE(PG8_SA(0, 1), cA + hstepA, voffA);
        if (wr == 1) PG8_BAR;
        PG8_WAIT_V(4); PG8_BAR;
        PG8_STAGE(PG8_SB(1, 0), cB + kstep, voffB); PG8_STAGE(PG8_SA(1, 0), cA + kstep, voffA); PG8_STAGE(PG8_SB(1, 1), cB + hstepB + kstep, voffB);
        PG8_WAIT_V(6); PG8_BAR;
    }
    for (;;) {
        const bool has_next = S.next(ui + 1, nxt);
        const char* nA = has_next ? (const char*)g.A + (size_t)nxt.pm * tstepA : cA; const char* nB = has_next ? (const char*)g.Bt + (size_t)nxt.pn * tstepB : cB;
        for (int t = 0; t < nt; t += 2) {
            const bool last = (t == nt - 2);
            const char* a1 = cA + (size_t)(t + 1) * kstep;
            const char* a2 = last ? nA : cA + (size_t)(t + 2) * kstep; const char* b2 = last ? nB : cB + (size_t)(t + 2) * kstep;
            const char* a3 = a2 + kstep; const char* b3 = b2 + kstep;
            if (last && has_next) S.a_ready(nxt);
            if constexpr (SP2) {
            PG8_LDB(B0, 0, 0); PG8_LDB(B1, 0, 1); PG8_SCHED; PG8_LDA(At, 0, 0); PG8_STAGE(PG8_SA(1, 1), a1 + hstepA, voffA);
            PG8_WAIT_V(8); PG8_WAIT_L(0); PG8_BAR; PG8_MMA(0, 0, At, B0); PG8_MMA(0, 1, At, B1); PG8_BAR; PG8_SCHED;
            PG8_LDA(At, 0, 1); PG8_STAGE(PG8_SB(0, 0), b2, voffB); PG8_STAGE(PG8_SB(0, 1), b2 + hstepB, voffB); PG8_STAGE(PG8_SA(0, 0), a2, voffA);
            PG8_WAIT_V(8); PG8_WAIT_L(0); PG8_BAR; PG8_MMA(1, 0, At, B0); PG8_MMA(1, 1, At, B1); PG8_BAR; PG8_SCHED;
            PG8_LDB(B0, 1, 0); PG8_LDB(B1, 1, 1); PG8_SCHED; PG8_LDA(At, 1, 0); PG8_STAGE(PG8_SA(0, 1), a2 + hstepA, voffA);
            PG8_WAIT_V(8); PG8_WAIT_L(0); PG8_BAR; PG8_MMA(0, 0, At, B0); PG8_MMA(0, 1, At, B1); PG8_BAR; PG8_SCHED;
            PG8_LDA(At, 1, 1); PG8_STAGE(PG8_SB(1, 0), b3, voffB); PG8_STAGE(PG8_SB(1, 1), b3 + hstepB, voffB); PG8_STAGE(PG8_SA(1, 0), a3, voffA);
            PG8_WAIT_V(8); PG8_WAIT_L(0); PG8_BAR; PG8_MMA(1, 0, At, B0); PG8_MMA(1, 1, At, B1); PG8_BAR; PG8_SCHED;
            } else {
            PG8_LDB(B0, 0, 0); PG8_SCHED; PG8_LDA(At, 0, 0); PG8_STAGE(PG8_SA(1, 1), a1 + hstepA, voffA);
            PG8_WAIT_L(8); PG8_BAR; PG8_WAIT_L(0); PG8_MMA(0, 0, At, B0); PG8_BAR; PG8_SCHED;
            PG8_LDB(B1, 0, 1); PG8_STAGE(PG8_SB(0, 0), b2, voffB);
            PG8_BAR; PG8_WAIT_L(0); PG8_MMA(0, 1, At, B1); PG8_BAR;
            PG8_LDA(At, 0, 1); PG8_STAGE(PG8_SA(0, 0), a2, voffA);
            PG8_BAR; PG8_WAIT_L(0); PG8_MMA(1, 0, At, B0); PG8_BAR; PG8_SCHED;
            PG8_STAGE(PG8_SB(0, 1), b2 + hstepB, voffB);
            PG8_WAIT_V(6); PG8_BAR; PG8_MMA(1, 1, At, B1); PG8_BAR;
            PG8_LDB(B0, 1, 0); PG8_SCHED; PG8_LDA(At, 1, 0); PG8_STAGE(PG8_SA(0, 1), a2 + hstepA, voffA);
            PG8_WAIT_L(8); PG8_BAR; PG8_WAIT_L(0); PG8_MMA(0, 0, At, B0); PG8_BAR; PG8_SCHED;
            PG8_LDB(B1, 1, 1); PG8_STAGE(PG8_SB(1, 0), b3, voffB);
            PG8_BAR; PG8_WAIT_L(0); PG8_MMA(0, 1, At, B1); PG8_BAR;
            PG8_LDA(At, 1, 1); PG8_STAGE(PG8_SA(1, 0), a3, voffA);
            PG8_BAR; PG8_WAIT_L(0); PG8_MMA(1, 0, At, B0); PG8_BAR; PG8_SCHED;
            PG8_STAGE(PG8_SB(1, 1), b3 + hstepB, voffB);
            PG8_WAIT_V(6); PG8_BAR; PG8_MMA(1, 1, At, B1); PG8_BAR;
            }
        }
        if constexpr (ALIGN_EPI) { if (wr == 0) PG8_BAR; }
        if constexpr (!Epi::AFTER_DRAIN) { E(acc, cur, wr, wc, fr, fq); S.done(cur); }
        if (!has_next) break;
#pragma unroll
        for (int a = 0; a < 2; ++a)
#pragma unroll
            for (int b = 0; b < 2; ++b)
#pragma unroll
                for (int m = 0; m < 4; ++m)
#pragma unroll
                    for (int n = 0; n < 2; ++n) acc[a][b][m][n] = (f32x4){0.f, 0.f, 0.f, 0.f};
        cur = nxt; cA = nA; cB = nB; ++ui;
        if constexpr (ALIGN_EPI) { if (wr == 1) PG8_BAR; }
    }
    PG8_WAIT_V(0);
    if constexpr (!ALIGN_EPI) { if (wr == 0) PG8_BAR; }
    PG8_BAR;
    if constexpr (Epi::AFTER_DRAIN) { E.fused(acc, cur, wr, wc, fr, fq, lds, wid, lane); S.done(cur); }
#undef PG8_SA
#undef PG8_SB
#undef PG8_STAGE
#undef PG8_LDA
#undef PG8_LDB
#undef PG8_MMA
#undef PG8_WAIT_V
#undef PG8_WAIT_L
#undef PG8_BAR
#undef PG8_SCHED
}
}

namespace cg = cooperative_groups;
using pg8::bf16_t; using pg8::bf16x8; using pg8::f32x4; using pg8::u32x4; using pg8::f32x2; using pg8::Unit; using pg8::cvt_pk_bf16;
#define LAS __attribute__((address_space(3)))
typedef short s16x4 __attribute__((ext_vector_type(4)));
typedef unsigned u32x2 __attribute__((ext_vector_type(2)));

constexpr int DM = 1024, NB = 32, RPB = 2304, MT = NB * RPB;
constexpr int HROWS = MT / 2;
constexpr int NTHR = 512, LDS_BYTES = 147456;
constexpr float LN_EPS = 1e-5f;
constexpr float DN_ALPHA = 1.6817928305074290f;

constexpr size_t SZ_W4 = (size_t)4096 * 1024 * 2;
constexpr size_t WS_MOD = 4096;
constexpr size_t WS_ROPE = WS_MOD + (size_t)4 * 33 * 6144 * 4;
constexpr size_t WS_CX = WS_ROPE + (size_t)2 * 2048 * 128 * 4;
constexpr size_t WS_WA_IN = WS_CX + (size_t)32 * 256 * 1024 * 4;
constexpr size_t WS_WA_OUT = WS_WA_IN + 2 * SZ_W4;
constexpr size_t WS_WB_QKV = WS_WA_OUT + SZ_W4;
constexpr size_t WS_WB_GATE = WS_WB_QKV + 2 * SZ_W4;
constexpr size_t WS_WB_OUT = WS_WB_GATE + 2 * SZ_W4;
constexpr size_t WS_W1 = WS_WB_OUT + SZ_W4;
constexpr size_t WS_W2 = WS_W1 + 4 * SZ_W4;
constexpr size_t WS_WS = WS_W2 + 4 * SZ_W4;
constexpr size_t WS_H = WS_WS + (size_t)2 * 8 * 128 * 128 * 2;
constexpr size_t WS_Z = WS_H + (size_t)MT * 1024 * 2;
constexpr size_t WS_ST = WS_Z + (size_t)MT * 4096 * 2;
constexpr size_t WS_FT = WS_ST + (size_t)HROWS * 128 * 4;
constexpr size_t WS_BAR = WS_FT + (size_t)HROWS * 16 * 4;
constexpr size_t WS_END = WS_BAR + 16384;
constexpr int CNT_WORD0 = 3584;
constexpr int MODN = 4 * 33 * 6144;

struct Params {
    const float *x, *c, *ctx, *c_ctx, *ada_w, *ada_b, *ln1_g, *ln1_b, *ln2_g, *ln2_b, *ffn_w1, *ffn_w2, *a_w_in, *a_b_in, *a_ln_g, *a_ln_b, *a_w_s, *a_b_s, *a_w_out, *b_w_in, *b_decay, *b_w_out;
    float* out; unsigned char* ws;
};
typedef const unsigned long long __attribute__((address_space(4)))* KP64;
__device__ __forceinline__ Params kparams() {
    Params r;
#if defined(__HIP_DEVICE_COMPILE__)
    KP64 kp = (KP64)__builtin_amdgcn_kernarg_segment_ptr(); asm volatile("" : "+s"(kp));
    unsigned long long* d = (unsigned long long*)&r;
#pragma unroll
    for (int i = 0; i < (int)(sizeof(Params) / 8); ++i) d[i] = kp[i];
#endif
    return r;
}

__device__ __forceinline__ float bflo(unsigned w) { return __uint_as_float(w << 16); }
__device__ __forceinline__ float bfhi(unsigned w) { return __uint_as_float(w & 0xffff0000u); }
__device__ __forceinline__ float silu_f(float x) { return x / (1.f + __expf(-x)); }
__device__ __forceinline__ float wave_sum(float v) {
#pragma unroll
    for (int o = 32; o >= 1; o >>= 1) v += __shfl_xor(v, o);
    return v;
}
__device__ __forceinline__ f32x4 mfma16(bf16x8 a, bf16x8 b, f32x4 c) { return __builtin_amdgcn_mfma_f32_16x16x32_bf16(a, b, c, 0, 0, 0); }
__device__ __forceinline__ bf16x8 frag_tr(const LAS unsigned char* T, int ld, int k0, int x0, int lane) {
    const int fq = lane >> 4, li = lane & 15, q = li >> 2, p = li & 3;
    const LAS unsigned char* a = T + (k0 + 8 * fq + q) * ld + (x0 + 4 * p) * 2;
    const s16x4 lo = __builtin_amdgcn_ds_read_tr16_b64_v4i16((LAS s16x4*)a);
    const s16x4 hi = __builtin_amdgcn_ds_read_tr16_b64_v4i16((LAS s16x4*)(a + 4 * ld));
    bf16x8 r; r[0] = lo[0]; r[1] = lo[1]; r[2] = lo[2]; r[3] = lo[3]; r[4] = hi[0]; r[5] = hi[1]; r[6] = hi[2]; r[7] = hi[3];
    return r;
}
__device__ __forceinline__ bf16x8 frag_row(const LAS unsigned char* T, int ld, int x0, int k0, int lane) {
    return *(const LAS bf16x8*)(T + (x0 + (lane & 15)) * ld + (k0 + 8 * (lane >> 4)) * 2);
}
__device__ __forceinline__ u32x2 pack4(f32x4 v) { u32x2 w; w.x = cvt_pk_bf16(v[0], v[1]); w.y = cvt_pk_bf16(v[2], v[3]); return w; }

#define XB_TMO      128
#define XB_XCNT(j)  (256  + 64 * (j))
#define XB_XSUB(j)  (1280 + 64 * (j))
#define XB_XGEN(j)  (2304 + 64 * (j))
#define XB_TOP      3328
#define XB_TOPGEN   3392
#define XCD_BAR_WORDS 3456
#define XB_SPIN_CAP (1u << 18)

__device__ __forceinline__ unsigned xb_ld(unsigned* p)              { return __hip_atomic_load(p, __ATOMIC_RELAXED, __HIP_MEMORY_SCOPE_AGENT); }
__device__ __forceinline__ unsigned xb_add(unsigned* p, unsigned v) { return __hip_atomic_fetch_add(p, v, __ATOMIC_RELAXED, __HIP_MEMORY_SCOPE_AGENT); }
__device__ __forceinline__ unsigned xb_xcc_id() { return (unsigned)__builtin_amdgcn_s_getreg((3 << 11) | 20) & 0xFu; }
#define XB_SPIN(cond, bar) do { unsigned _sp = 0; while (cond) { __builtin_amdgcn_s_sleep(1); \
    if ((++_sp & 255u) == 0u) { if (xb_ld(&(bar)[XB_TMO])) break; if (_sp > XB_SPIN_CAP) { atomicAdd(&(bar)[XB_TMO], 1u); break; } } } } while (0)

struct XcdBarrier {
    unsigned* bar; unsigned x;
    volatile LAS unsigned* st;
};

__device__ __forceinline__ XcdBarrier xcd_barrier_post(unsigned* bar, volatile LAS unsigned* st) {
    XcdBarrier b; b.bar = bar; b.x = xb_xcc_id(); b.st = st;
    if (threadIdx.x == 0) (void)xb_add(&bar[XB_XCNT(b.x)], 1u);
    return b;
}
__device__ __forceinline__ void xcd_barrier_complete(unsigned* bar, unsigned x, unsigned& nloc, unsigned& nx) {
    const unsigned G = gridDim.x * gridDim.y * gridDim.z;
    unsigned sum, cnt, mine, sp = 0u;
    for (;;) {
        sum = 0u; cnt = 0u; mine = 0u;
#pragma unroll
        for (unsigned j = 0; j < 16; ++j) { const unsigned c = xb_ld(&bar[XB_XCNT(j)]); sum += c; cnt += (c > 0u) ? 1u : 0u; mine = (j == x) ? c : mine; }
        if (sum == G) break;
        __builtin_amdgcn_s_sleep(1);
        if ((++sp & 255u) == 0u) { if (xb_ld(&bar[XB_TMO])) break; if (sp > XB_SPIN_CAP) { atomicAdd(&bar[XB_TMO], 1u); break; } }
    }
    nloc = mine > 0u ? mine : 1u; nx = cnt > 0u ? cnt : 1u;
}

__device__ __forceinline__ void xcd_barrier(const XcdBarrier& b) {
    asm volatile("s_waitcnt vmcnt(0)" ::: "memory");
    __syncthreads();
    if (threadIdx.x == 0) {
        unsigned* bar = b.bar;
        __builtin_amdgcn_s_waitcnt(0);
        unsigned nloc = b.st[0], nx = b.st[1];
        if (nloc == 0u) { xcd_barrier_complete(bar, b.x, nloc, nx); b.st[0] = nloc; b.st[1] = nx; }
        const unsigned old = xb_add(&bar[XB_XSUB(b.x)], 1u);
        const unsigned gen = old / nloc;
        if (old + 1u == (gen + 1u) * nloc) {
            __builtin_amdgcn_fence(__ATOMIC_RELEASE, "agent");
            asm volatile("s_waitcnt vmcnt(0)" ::: "memory");
            const unsigned og = xb_add(&bar[XB_TOP], 1u);
            const unsigned tg = og / nx;
            if (og + 1u == (tg + 1u) * nx) xb_add(&bar[XB_TOPGEN], 1u);
            else XB_SPIN(xb_ld(&bar[XB_TOPGEN]) == tg, bar);
            __builtin_amdgcn_fence(__ATOMIC_ACQUIRE, "agent");
            xb_add(&bar[XB_XGEN(b.x)], 1u);
            asm volatile("s_waitcnt vmcnt(0)" ::: "memory");
        } else {
            XB_SPIN(xb_ld(&bar[XB_XGEN(b.x)]) == gen, bar);
            __builtin_amdgcn_fence(__ATOMIC_ACQUIRE, "agent");
            asm volatile("s_waitcnt vmcnt(0)" ::: "memory");
        }
    }
    __syncthreads();
}

struct Sched {
    int nM, nN, nwg, G, c, pm_off, skip;
    __device__ void init(int nM_, int nN_, int G_, int c_, int pm_off_, int skip_) { nM = nM_; nN = nN_; nwg = nM * nN; G = G_; c = c_; pm_off = pm_off_; skip = skip_; }
    __device__ bool next(int i, Unit& u) const {
        const long L = (long)i * G + c; if (L >= nwg) return false;
        int wgid = (int)L; { const int q = nwg / pg8::NXCD, r = nwg % pg8::NXCD, xcd = wgid % pg8::NXCD, off = wgid / pg8::NXCD; wgid = (xcd < r ? xcd * (q + 1) : r * (q + 1) + (xcd - r) * q) + off; }
        const int nig = pg8::WGM * nN, gid = wgid / nig, fm = gid * pg8::WGM, gsz = (nM - fm) < pg8::WGM ? (nM - fm) : pg8::WGM;
        int pm = fm + ((wgid % nig) % gsz); u.pn = (wgid % nig) / gsz;
        if (skip) pm = (pm >> 3) * 9 + 1 + (pm & 7);
        u.pm = pm + pm_off; return true;
    }
    __device__ __forceinline__ void a_ready(const Unit&) const {}
    __device__ __forceinline__ void done(const Unit&) const {}
};

template <int ACT> struct EpiAct {
    static constexpr bool PERM = true, AFTER_DRAIN = false;
    bf16_t* O; int ldc; const float* bias;
    __device__ __forceinline__ void operator()(const f32x4 (&acc)[2][2][4][2], const Unit& u, int wr, int wc, int fr, int fq) const {
        const int row0 = u.pm * 256 + wr * 64 + fr, col0 = u.pn * 256 + wc * 32 + 8 * fq;
        f32x4 bv[2][2];
#pragma unroll
        for (int bj = 0; bj < 2; ++bj)
#pragma unroll
            for (int n = 0; n < 2; ++n) bv[bj][n] = (ACT == 1) ? *(const f32x4*)(bias + col0 + bj * 128 + 4 * n) : (f32x4){0.f, 0.f, 0.f, 0.f};
#pragma unroll
        for (int ai = 0; ai < 2; ++ai)
#pragma unroll
            for (int m = 0; m < 4; ++m) { bf16_t* rowp = O + (size_t)(row0 + ai * 128 + m * 16) * ldc + col0;
#pragma unroll
                for (int bj = 0; bj < 2; ++bj) { f32x4 v0 = acc[ai][bj][m][0], v1 = acc[ai][bj][m][1];
                    if (ACT == 1) { v0 = v0 + bv[bj][0]; v1 = v1 + bv[bj][1];
                        f32x2 a = pg8::gelu_pk((f32x2){v0[0], v0[1]}), b = pg8::gelu_pk((f32x2){v0[2], v0[3]}), c = pg8::gelu_pk((f32x2){v1[0], v1[1]}), d = pg8::gelu_pk((f32x2){v1[2], v1[3]});
                        v0 = (f32x4){a.x, a.y, b.x, b.y}; v1 = (f32x4){c.x, c.y, d.x, d.y}; }
                    if (ACT == 2) {
#pragma unroll
                        for (int j = 0; j < 4; ++j) { const float p0 = fmaxf(v0[j], 0.f), p1 = fmaxf(v1[j], 0.f); v0[j] = p0 * p0; v1[j] = p1 * p1; } }
                    u32x4 w; w.x = cvt_pk_bf16(v0[0], v0[1]); w.y = cvt_pk_bf16(v0[2], v0[3]); w.z = cvt_pk_bf16(v1[0], v1[1]); w.w = cvt_pk_bf16(v1[2], v1[3]);
                    *(u32x4*)(rowp + bj * 128) = w; } }
    }
};
struct EpiQKV {
    static constexpr bool PERM = true, AFTER_DRAIN = false;
    bf16_t* O; const float* rc; const float* rs;
    __device__ __forceinline__ void operator()(const f32x4 (&acc)[2][2][4][2], const Unit& u, int wr, int wc, int fr, int fq) const {
        const int pb = u.pm % 9, kind = u.pn >> 2;
        const bool rope = (pb != 0) && (kind < 2);
        const float sc = (kind == 1) ? 0.0625f : 1.f;
        const int row0 = u.pm * 256 + wr * 64 + fr, col0 = u.pn * 256 + wc * 32 + 8 * fq, i0 = wc * 32 + 8 * fq;
#pragma unroll
        for (int ai = 0; ai < 2; ++ai)
#pragma unroll
            for (int m = 0; m < 4; ++m) {
                bf16_t* rowp = O + (ptrdiff_t)(row0 + ai * 128 + m * 16) * 4096 + col0;
                f32x4 a0 = acc[ai][0][m][0] * sc, a1 = acc[ai][0][m][1] * sc, b0 = acc[ai][1][m][0] * sc, b1 = acc[ai][1][m][1] * sc;
                if (rope) {
                    const int t = (pb - 1) * 256 + ai * 128 + wr * 64 + m * 16 + fr;
                    const f32x4 c0 = *(const f32x4*)(rc + t * 128 + i0), c1 = *(const f32x4*)(rc + t * 128 + i0 + 4);
                    const f32x4 s0 = *(const f32x4*)(rs + t * 128 + i0), s1 = *(const f32x4*)(rs + t * 128 + i0 + 4);
                    const f32x4 o0 = a0 * c0 - b0 * s0, o1 = a1 * c1 - b1 * s1, p0 = a0 * s0 + b0 * c0, p1 = a1 * s1 + b1 * c1;
                    a0 = o0; a1 = o1; b0 = p0; b1 = p1;
                }
                u32x4 w; w.x = cvt_pk_bf16(a0[0], a0[1]); w.y = cvt_pk_bf16(a0[2], a0[3]); w.z = cvt_pk_bf16(a1[0], a1[1]); w.w = cvt_pk_bf16(a1[2], a1[3]);
                *(u32x4*)rowp = w;
                w.x = cvt_pk_bf16(b0[0], b0[1]); w.y = cvt_pk_bf16(b0[2], b0[3]); w.z = cvt_pk_bf16(b1[0], b1[1]); w.w = cvt_pk_bf16(b1[2], b1[3]);
                *(u32x4*)(rowp + 128) = w;
            }
    }
};
struct EpiGate {
    static constexpr bool PERM = true, AFTER_DRAIN = false;
    bf16_t* O; const float* ST;
    __device__ __forceinline__ void operator()(const f32x4 (&acc)[2][2][4][2], const Unit& u, int wr, int wc, int fr, int fq) const {
        const int row0 = u.pm * 256 + wr * 64 + fr, ch0 = u.pn * 128 + wc * 32 + 8 * fq, h = ch0 >> 9;
#pragma unroll
        for (int ai = 0; ai < 2; ++ai)
#pragma unroll
            for (int m = 0; m < 4; ++m) {
                const ptrdiff_t row = row0 + ai * 128 + m * 16;
                const f32x4 st4 = *(const f32x4*)(ST + (row * 4 + h) * 4);
                const float mean[2] = {st4[0], st4[2]}, rstd[2] = {st4[1], st4[3]};
                bf16_t* op = O + row * 4096 + ch0;
                const u32x4 of = *(const u32x4*)op, ob = *(const u32x4*)(op + 2048);
                float y[8];
#pragma unroll
                for (int e = 0; e < 8; ++e) {
                    const unsigned wf = of[e >> 1], wb = ob[e >> 1];
                    const float vf = (e & 1) ? bfhi(wf) : bflo(wf), vb = (e & 1) ? bfhi(wb) : bflo(wb);
                    const float gf = acc[ai][0][m][e >> 2][e & 3], gb = acc[ai][1][m][e >> 2][e & 3];
                    y[e] = (vf - mean[0]) * rstd[0] * (gf * __builtin_amdgcn_rcpf(1.f + __expf(-gf))) + (vb - mean[1]) * rstd[1] * (gb * __builtin_amdgcn_rcpf(1.f + __expf(-gb)));
                }
                u32x4 w; w.x = cvt_pk_bf16(y[0], y[1]); w.y = cvt_pk_bf16(y[2], y[3]); w.z = cvt_pk_bf16(y[4], y[5]); w.w = cvt_pk_bf16(y[6], y[7]);
                *(u32x4*)op = w;
            }
    }
};

template <class Epi> __device__ __forceinline__ void run_gemm(LAS unsigned char* lds, const bf16_t* A, int lda, const bf16_t* Bt, int K, int nM, int nN, int pm_off, int skip, const Epi& E) {
    pg8::Gemm g{A, Bt, K, lda, K}; Sched S; S.init(nM, nN, (int)gridDim.x, (int)blockIdx.x, pm_off, skip);
    pg8::gemm_phase<Epi, Sched, true, true>(lds, g, S, E);
}

__device__ __forceinline__ void conv_tile(LAS unsigned char* lds, const float* src, int ld, int col0, int k0, int n0, bf16_t* dst, int Kdst, bool gate, int tid) {
    LAS bf16_t* T = (LAS bf16_t*)lds;
#pragma unroll
    for (int it = 0; it < 2; ++it) {
        const int kk = (tid >> 4) + 32 * it, n4 = (tid & 15) * 4;
        const f32x4 v = *(const f32x4*)(src + (size_t)(k0 + kk) * ld + col0 + n0 + n4);
        const unsigned p01 = cvt_pk_bf16(v[0], v[1]), p23 = cvt_pk_bf16(v[2], v[3]);
        T[(n4 + 0) * 72 + kk] = (bf16_t)(p01 & 0xffffu); T[(n4 + 1) * 72 + kk] = (bf16_t)(p01 >> 16);
        T[(n4 + 2) * 72 + kk] = (bf16_t)(p23 & 0xffffu); T[(n4 + 3) * 72 + kk] = (bf16_t)(p23 >> 16);
    }
    __syncthreads();
    {
        const int n = tid >> 3, kc = (tid & 7) * 8;
        const u32x4 val = *(const LAS u32x4*)(T + n * 72 + kc);
        int nn = n0 + n;
        if (gate) { const int dir = nn >> 11, ch = nn & 2047; nn = (ch >> 7) * 256 + dir * 128 + (ch & 127); }
        *(u32x4*)(dst + (size_t)nn * Kdst + k0 + kc) = val;
    }
    __syncthreads();
}

__device__ __forceinline__ void prologue0(LAS unsigned char* lds) {
    const Params p = kparams();
    int tid = threadIdx.x; asm volatile("" : "+v"(tid));
    unsigned char* ws = p.ws;
    constexpr int N_MOD = 192, N_CONV = 16384, N_WS = 64, N_ROPE = 64, N_ITEMS = N_MOD + N_CONV + N_WS + N_ROPE;
    for (int it = blockIdx.x; it < N_ITEMS; it += gridDim.x) {
        if (it < N_MOD) {
            const int l = it / 48, rem = it - l * 48, cb = rem >> 2, kq = rem & 3, n = cb * 512 + tid;
            LAS float* sct = (LAS float*)lds;
            float acc[36];
            const float b0 = kq == 0 ? p.ada_b[l * 6144 + n] : 0.f;
#pragma unroll
            for (int r = 0; r < 36; ++r) acc[r] = b0;
            for (int idx = tid; idx < 36 * 256; idx += NTHR) {
                const int r = idx >> 8, kk = idx & 255;
                float v = 0.f;
                if (r < 32) v = silu_f(p.c[r * 1024 + kq * 256 + kk]); else if (r == 32) v = silu_f(p.c_ctx[kq * 256 + kk]);
                sct[kk * 36 + r] = v;
            }
            __syncthreads();
            const float* wp = p.ada_w + ((size_t)l * 1024 + kq * 256) * 6144 + n;
            for (int k8 = 0; k8 < 256; k8 += 8) {
                float w[8];
#pragma unroll
                for (int u = 0; u < 8; ++u) w[u] = wp[(size_t)(k8 + u) * 6144];
#pragma unroll
                for (int u = 0; u < 8; ++u)
#pragma unroll
                    for (int r4 = 0; r4 < 9; ++r4) {
                        const f32x4 sv = *(const LAS f32x4*)(sct + (k8 + u) * 36 + r4 * 4);
                        acc[r4 * 4 + 0] += sv[0] * w[u]; acc[r4 * 4 + 1] += sv[1] * w[u]; acc[r4 * 4 + 2] += sv[2] * w[u]; acc[r4 * 4 + 3] += sv[3] * w[u];
                    }
            }
            float* part = (float*)(ws + WS_ST) + (size_t)kq * MODN;
#pragma unroll
            for (int r = 0; r < 33; ++r) part[((size_t)l * 33 + r) * 6144 + n] = acc[r];
            __syncthreads();
        } else if (it < N_MOD + N_CONV) {
            const int T = it - N_MOD;
            const float* src; int ld, col0 = 0, kt, nt, Kdst; bf16_t* dst; bool gate = false;
            if (T < 2048) { const int j = T >> 10, t = T & 1023; kt = t >> 6; nt = t & 63; src = p.a_w_in + (size_t)j * 1024 * 4096; ld = 4096; dst = (bf16_t*)(ws + WS_WA_IN + j * SZ_W4); Kdst = 1024; }
            else if (T < 3072) { const int T2 = T - 2048, j = T2 >> 9, t = T2 & 511; kt = t >> 4; nt = t & 15; src = p.a_w_out + (size_t)j * 2048 * 1024; ld = 1024; dst = (bf16_t*)(ws + WS_WA_OUT + j * (SZ_W4 / 2)); Kdst = 2048; }
            else if (T < 5120) { const int T2 = T - 3072, j = T2 >> 10, t = T2 & 1023; kt = t >> 6; nt = t & 63; src = p.b_w_in + (size_t)j * 1024 * 8192; ld = 8192; dst = (bf16_t*)(ws + WS_WB_QKV + j * SZ_W4); Kdst = 1024; }
            else if (T < 7168) { const int T2 = T - 5120, j = T2 >> 10, t = T2 & 1023; kt = t >> 6; nt = t & 63; src = p.b_w_in + (size_t)j * 1024 * 8192; ld = 8192; col0 = 4096; dst = (bf16_t*)(ws + WS_WB_GATE + j * SZ_W4); Kdst = 1024; gate = true; }
            else if (T < 8192) { const int T2 = T - 7168, j = T2 >> 9, t = T2 & 511; kt = t >> 4; nt = t & 15; src = p.b_w_out + (size_t)j * 2048 * 1024; ld = 1024; dst = (bf16_t*)(ws + WS_WB_OUT + j * (SZ_W4 / 2)); Kdst = 2048; }
            else if (T < 12288) { const int T2 = T - 8192, l = T2 >> 10, t = T2 & 1023; kt = t >> 6; nt = t & 63; src = p.ffn_w1 + (size_t)l * 1024 * 4096; ld = 4096; dst = (bf16_t*)(ws + WS_W1 + l * SZ_W4); Kdst = 1024; }
            else { const int T2 = T - 12288, l = T2 >> 10, t = T2 & 1023; kt = t >> 4; nt = t & 15; src = p.ffn_w2 + (size_t)l * 4096 * 1024; ld = 1024; dst = (bf16_t*)(ws + WS_W2 + l * SZ_W4); Kdst = 4096; }
            conv_tile(lds, src, ld, col0, kt * 64, nt * 64, dst, Kdst, gate, tid);
        } else if (it < N_MOD + N_CONV + N_WS) {
            const int base = (it - N_MOD - N_CONV) * 4096 + tid * 8;
            const f32x4 v0 = *(const f32x4*)(p.a_w_s + base), v1 = *(const f32x4*)(p.a_w_s + base + 4);
            u32x4 w; w.x = cvt_pk_bf16(v0[0], v0[1]); w.y = cvt_pk_bf16(v0[2], v0[3]); w.z = cvt_pk_bf16(v1[0], v1[1]); w.w = cvt_pk_bf16(v1[2], v1[3]);
            *(u32x4*)((bf16_t*)(ws + WS_WS) + base) = w;
        } else {
            float* rc = (float*)(ws + WS_ROPE); float* rs = rc + 2048 * 128;
            const int base = (it - N_MOD - N_CONV - N_WS) * 4096 + tid * 8;
#pragma unroll
            for (int e = 0; e < 8; ++e) {
                const int id = base + e, t = id >> 7, i = id & 127, f = i & 63;
                const float pos = (float)((i < 64) ? (t >> 6) : (t & 63));
                const float inv = __builtin_amdgcn_exp2f(-(float)f * (13.287712379549449f / 64.f));
                const float ang = pos * inv;
                float rev = ang * 0.15915494309189535f; rev -= rintf(rev);
                rc[id] = __builtin_amdgcn_cosf(rev); rs[id] = __builtin_amdgcn_sinf(rev);
            }
        }
    }
}

__device__ __forceinline__ void prologue1() {
    const Params p = kparams();
    int tid = threadIdx.x; asm volatile("" : "+v"(tid));
    const int lane = tid & 63, wid = tid >> 6;
    float* mod = (float*)(p.ws + WS_MOD);
    const float* part = (const float*)(p.ws + WS_ST);
    for (int i = (blockIdx.x * NTHR + tid) * 4; i < MODN; i += gridDim.x * NTHR * 4)
        *(f32x4*)(mod + i) = (*(const f32x4*)(part + i) + *(const f32x4*)(part + MODN + i)) + (*(const f32x4*)(part + 2 * MODN + i) + *(const f32x4*)(part + 3 * MODN + i));
    bf16_t* H = (bf16_t*)(p.ws + WS_H);
    for (int r = blockIdx.x * 8 + wid; r < MT; r += gridDim.x * 8) {
        const int b = r / RPB, j = r - b * RPB; const bool isctx = j < 256;
        const float* xs = isctx ? p.ctx + ((size_t)b * 256 + j) * 1024 : p.x + ((size_t)b * 2048 + (j - 256)) * 1024;
        const float* mr = part + (size_t)(isctx ? 32 : b) * 6144;
#pragma unroll
        for (int q = 0; q < 4; ++q) {
            const int col = q * 256 + lane * 4;
            const f32x4 xv = *(const f32x4*)(xs + col);
            const f32x4 sh = (*(const f32x4*)(mr + col) + *(const f32x4*)(mr + MODN + col)) + (*(const f32x4*)(mr + 2 * MODN + col) + *(const f32x4*)(mr + 3 * MODN + col));
            const f32x4 sc = (*(const f32x4*)(mr + 1024 + col) + *(const f32x4*)(mr + MODN + 1024 + col)) + (*(const f32x4*)(mr + 2 * MODN + 1024 + col) + *(const f32x4*)(mr + 3 * MODN + 1024 + col));
            const f32x4 h = xv * (sc + 1.0f) + sh;
            *(u32x2*)(H + (size_t)r * 1024 + col) = pack4(h);
        }
    }
}

__device__ __forceinline__ void ln_phase(int l, int which, bool last, bool redirect = false) {
    const Params p = kparams();
    const float* xl_src = (l == 0 && which == 0) ? p.x : p.out; const float* xc_src = (l == 0 && which == 0) ? p.ctx : (const float*)(p.ws + WS_CX);
    const int gate_off = which ? 5120 : 2048; const float* lng = (which ? p.ln2_g : p.ln1_g) + l * 1024; const float* lnb = (which ? p.ln2_b : p.ln1_b) + l * 1024;
    const int l_next = which ? (last ? l : l + 1) : l, sh_off = which ? 0 : 3072, sc_off = which ? 1024 : 4096; const bool write_h = which ? !last : true, skipctx = last;
    int tid = threadIdx.x; asm volatile("" : "+v"(tid));
    const int lane = tid & 63, wid = tid >> 6;
    const float* mod = (const float*)(p.ws + WS_MOD);
    bf16_t* H = (bf16_t*)(p.ws + WS_H);
    float* CX = (float*)(p.ws + WS_CX);
    const int nw = gridDim.x * 8;
    for (int rb = blockIdx.x * 8 + wid; rb < MT; rb += 2 * nw) {
        const float* xs[2]; float* xd[2]; int mrow[2]; bool act[2]; size_t hoff[2];
        f32x4 t[2][4]; float s[2];
#pragma unroll
        for (int k = 0; k < 2; ++k) {
            const int r = rb + k * nw; const int rr = r < MT ? r : rb;
            const int b = rr / RPB, j = rr - b * RPB; const bool isctx = j < 256;
            act[k] = (r < MT) && !(isctx && skipctx);
            const size_t xo = isctx ? ((size_t)b * 256 + j) * 1024 : ((size_t)b * 2048 + (j - 256)) * 1024;
            xs[k] = (isctx ? xc_src : xl_src) + xo; xd[k] = (isctx ? CX : p.out) + xo; mrow[k] = isctx ? 32 : b; hoff[k] = (size_t)rr * 1024;
            const float* gate = mod + ((size_t)l * 33 + mrow[k]) * 6144 + gate_off;
            s[k] = 0.f;
#pragma unroll
            for (int q = 0; q < 4; ++q) {
                const int col = q * 256 + lane * 4;
                const f32x4 xv = *(const f32x4*)(xs[k] + col), gv = *(const f32x4*)(gate + col);
                const u32x2 yw = *(const u32x2*)(H + hoff[k] + col);
                const f32x4 yv = {bflo(yw.x), bfhi(yw.x), bflo(yw.y), bfhi(yw.y)};
                t[k][q] = xv * DN_ALPHA + gv * yv;
                s[k] += (t[k][q][0] + t[k][q][1]) + (t[k][q][2] + t[k][q][3]);
            }
        }
#pragma unroll
        for (int k = 0; k < 2; ++k) {
            const float mean = wave_sum(s[k]) * (1.f / 1024.f);
            float v = 0.f;
#pragma unroll
            for (int q = 0; q < 4; ++q) { const f32x4 d = t[k][q] - mean; v += (d[0] * d[0] + d[1] * d[1]) + (d[2] * d[2] + d[3] * d[3]); }
            const float rstd = 1.0f / sqrtf(wave_sum(v) * (1.f / 1024.f) + LN_EPS);
            const float* shp = mod + ((size_t)l_next * 33 + mrow[k]) * 6144 + sh_off;
            const float* scp = mod + ((size_t)l_next * 33 + mrow[k]) * 6144 + sc_off;
            if (act[k]) {
#pragma unroll
                for (int q = 0; q < 4; ++q) {
                    const int col = q * 256 + lane * 4;
                    const f32x4 g4 = *(const f32x4*)(lng + col), b4 = *(const f32x4*)(lnb + col);
                    const f32x4 xn = (t[k][q] - mean) * rstd * g4 + b4;
                    if (redirect) { *(f32x4*)((float*)(p.ws + WS_Z) + hoff[k] + col) = xn; *(u32x2*)((bf16_t*)(p.ws + WS_Z) + (size_t)MT * 2048 + hoff[k] + col) = pack4(xn); }
                    else {
                    *(f32x4*)(xd[k] + col) = xn;
                    if (write_h) {
                        const f32x4 sh = *(const f32x4*)(shp + col), sc = *(const f32x4*)(scp + col);
                        *(u32x2*)(H + hoff[k] + col) = pack4(xn * (sc + 1.0f) + sh);
                    }
                    }
                }
            }
        }
    }
}

__device__ __forceinline__ void gating_phase(LAS unsigned char* lds, int jl, bool redirect = false) {
    const Params p = kparams();
    int tid_ = threadIdx.x; asm volatile("" : "+v"(tid_));
    const int tid = tid_, lane = tid & 63, wid = tid >> 6, fr = lane & 15, fq = lane >> 4;
    bf16_t* Z = (bf16_t*)(p.ws + WS_Z);
    const bf16_t* Wsb = (const bf16_t*)(p.ws + WS_WS) + (size_t)jl * 8 * 128 * 128;
    const float* lng = p.a_ln_g + jl * 2048; const float* lnb = p.a_ln_b + jl * 2048; const float* bs = p.a_b_s + jl * 8 * 128;
    LAS unsigned char* VN = lds;
    LAS unsigned char* WSI = lds + 67584;
    LAS float* STAT = (LAS float*)(lds + 102400);
    const int wc2 = wid & 3, wi2 = wid >> 2;
    for (int ci = blockIdx.x; ci < MT / 128; ci += gridDim.x) {
        const size_t row0 = (size_t)ci * 128;
        for (int tt = 0; tt < 16; ++tt) {
            const int j = wid * 16 + tt;
            const bf16_t* vp = Z + (row0 + j) * 4096 + 2048 + lane * 8;
            u32x4 raw[4]; float s = 0.f;
#pragma unroll
            for (int q = 0; q < 4; ++q) { raw[q] = *(const u32x4*)(vp + q * 512);
#pragma unroll
                for (int e = 0; e < 4; ++e) s += bflo(raw[q][e]) + bfhi(raw[q][e]); }
            const float mean = wave_sum(s) * (1.f / 2048.f);
            float v = 0.f;
#pragma unroll
            for (int q = 0; q < 4; ++q)
#pragma unroll
                for (int e = 0; e < 4; ++e) { const float d0 = bflo(raw[q][e]) - mean, d1 = bfhi(raw[q][e]) - mean; v += d0 * d0 + d1 * d1; }
            const float rstd = 1.0f / sqrtf(wave_sum(v) * (1.f / 2048.f) + LN_EPS);
            if (lane == 0) { STAT[j * 2] = mean; STAT[j * 2 + 1] = rstd; }
        }
        __syncthreads();
        for (int g = 0; g < 8; ++g) {
#pragma unroll
            for (int x = 0; x < 8; ++x) {
                const int q = tid + 512 * x, j = q >> 5, cc = (q & 31) * 8;
                const u32x4 raw = *(const u32x4*)(Z + (row0 + j) * 4096 + 2048 + g * 256 + cc);
                const float mean = STAT[j * 2], rstd = STAT[j * 2 + 1];
                const f32x4 g0 = *(const f32x4*)(lng + g * 256 + cc), g1 = *(const f32x4*)(lng + g * 256 + cc + 4), b0 = *(const f32x4*)(lnb + g * 256 + cc), b1 = *(const f32x4*)(lnb + g * 256 + cc + 4);
                u32x4 w;
                w.x = cvt_pk_bf16((bflo(raw.x) - mean) * rstd * g0[0] + b0[0], (bfhi(raw.x) - mean) * rstd * g0[1] + b0[1]);
                w.y = cvt_pk_bf16((bflo(raw.y) - mean) * rstd * g0[2] + b0[2], (bfhi(raw.y) - mean) * rstd * g0[3] + b0[3]);
                w.z = cvt_pk_bf16((bflo(raw.z) - mean) * rstd * g1[0] + b1[0], (bfhi(raw.z) - mean) * rstd * g1[1] + b1[1]);
                w.w = cvt_pk_bf16((bflo(raw.w) - mean) * rstd * g1[2] + b1[2], (bfhi(raw.w) - mean) * rstd * g1[3] + b1[3]);
                *(LAS u32x4*)(VN + j * 528 + cc * 2) = w;
            }
#pragma unroll
            for (int x = 0; x < 4; ++x) {
                const int q = tid + 512 * x, i = q >> 4, jc = (q & 15) * 8;
                *(LAS u32x4*)(WSI + i * 272 + jc * 2) = *(const u32x4*)(Wsb + (size_t)g * 16384 + i * 128 + jc);
            }
            __syncthreads();
            f32x4 acc[4][4];
#pragma unroll
            for (int a = 0; a < 4; ++a)
#pragma unroll
                for (int b = 0; b < 4; ++b) acc[a][b] = (f32x4){0.f, 0.f, 0.f, 0.f};
#pragma unroll
            for (int ks = 0; ks < 4; ++ks) {
                bf16x8 af[4], bf[4];
#pragma unroll
                for (int ct = 0; ct < 4; ++ct) af[ct] = frag_tr(VN, 528, ks * 32, (4 * wc2 + ct) * 16, lane);
#pragma unroll
                for (int it = 0; it < 4; ++it) bf[it] = frag_row(WSI, 272, (4 * wi2 + it) * 16, ks * 32, lane);
#pragma unroll
                for (int ct = 0; ct < 4; ++ct)
#pragma unroll
                    for (int it = 0; it < 4; ++it) acc[ct][it] = mfma16(af[ct], bf[it], acc[ct][it]);
            }
#pragma unroll
            for (int it = 0; it < 4; ++it) {
                const int i = (4 * wi2 + it) * 16 + fr; const float bsv = bs[g * 128 + i];
#pragma unroll
                for (int ct = 0; ct < 4; ++ct) {
                    bf16_t* up = Z + (row0 + i) * 4096 + g * 256 + (4 * wc2 + ct) * 16 + 4 * fq;
                    const u32x2 uu = *(const u32x2*)up;
                    const f32x4 sv = acc[ct][it] + bsv;
                    const f32x4 o = {bflo(uu.x) * sv[0], bfhi(uu.x) * sv[1], bflo(uu.y) * sv[2], bfhi(uu.y) * sv[3]};
                    if (redirect) *(u32x2*)((bf16_t*)(p.ws + WS_H) + ((row0 + i) & 0x7fff) * 2048 + g * 256 + (4 * wc2 + ct) * 16 + 4 * fq) = pack4(o); else *(u32x2*)up = pack4(o);
                }
            }
            __syncthreads();
        }
    }
}

__device__ __forceinline__ void retention_phase(LAS unsigned char* lds, int jl) {
    const Params p = kparams();
    const bf16_t* QKV = (const bf16_t*)(p.ws + WS_Z);
    bf16_t* O = (bf16_t*)(p.ws + WS_Z) + (size_t)HROWS * 4096;
    float* ST = (float*)(p.ws + WS_ST);
    LAS unsigned char* QH = lds;
    LAS unsigned char* KH = lds + 34816;
    LAS unsigned char* SH = lds + 69632;
    LAS unsigned char* VZ = lds + 104448;
    for (int idx = blockIdx.x; idx < 512; idx += gridDim.x) {
        const int es = idx & 3, dir = (idx >> 2) & 1, h = (idx >> 3) & 3, bl = idx >> 5;
        const float lg = log1pf(-__expf(p.b_decay[(jl * 2 + dir) * 4 + h]));
        const float gc = __expf(lg * 128.f);
        f32x4 accS[2][2][4];
#pragma unroll
        for (int a = 0; a < 2; ++a)
#pragma unroll
            for (int b = 0; b < 2; ++b)
#pragma unroll
                for (int c = 0; c < 4; ++c) accS[a][b][c] = (f32x4){0.f, 0.f, 0.f, 0.f};
        u32x4 rq[4], rk[4], rv[4];
#define RET_CHUNK(st_) ((dir == 0) ? (st_) : ((st_) < 2 ? 1 - (st_) : 19 - (st_)))
#define RET_LOADQK(r0_, dh_) do { const bf16_t* rp_ = QKV + ((r0_) + (tidp >> 4)) * 4096 + h * 256 + (dh_) * 128 + (tidp & 15) * 8; \
        _Pragma("unroll") for (int x_ = 0; x_ < 4; ++x_) { rq[x_] = *(const u32x4*)(rp_ + x_ * 32 * 4096); rk[x_] = *(const u32x4*)(rp_ + 1024 + x_ * 32 * 4096); } } while (0)
#define RET_LOADV(r0_) do { const bf16_t* rp_ = QKV + ((r0_) + (tidp >> 4)) * 4096 + 2048 + h * 512 + es * 128 + (tidp & 15) * 8; \
        _Pragma("unroll") for (int x_ = 0; x_ < 4; ++x_) rv[x_] = *(const u32x4*)(rp_ + x_ * 32 * 4096); } while (0)
#define RET_BAR() do { asm volatile("s_waitcnt lgkmcnt(0)" ::: "memory"); __builtin_amdgcn_s_barrier(); asm volatile("" ::: "memory"); } while (0)
        {
            int tidp = threadIdx.x; asm volatile("" : "+v"(tidp));
            const size_t r0 = (size_t)bl * RPB + RET_CHUNK(0) * 128;
            RET_LOADV(r0); RET_LOADQK(r0, 0);
        }
        for (int step = 0; step < 18; ++step) {
            int tid_ = threadIdx.x; asm volatile("" : "+v"(tid_));
            const int tid = tid_, tidp = tid_, lane = tid & 63, wid = __builtin_amdgcn_readfirstlane(tid >> 6), fr = lane & 15, fq = lane >> 4;
            const int wlo = wid & 3, whi = wid >> 2;
            const int n = RET_CHUNK(step);
            const size_t row0 = (size_t)bl * RPB + n * 128;
            const size_t row0n = (size_t)bl * RPB + RET_CHUNK(step + 1 < 18 ? step + 1 : step) * 128;
            f32x4 accP[4][2], accO[4][2];
#pragma unroll
            for (int a = 0; a < 4; ++a)
#pragma unroll
                for (int b = 0; b < 2; ++b) { accP[a][b] = (f32x4){0.f, 0.f, 0.f, 0.f}; accO[a][b] = (f32x4){0.f, 0.f, 0.f, 0.f}; }
            bool pv_ok[4][2];
#pragma unroll
            for (int jt = 0; jt < 4; ++jt)
#pragma unroll
                for (int it = 0; it < 2; ++it) pv_ok[jt][it] = dir ? (4 * whi + jt >= 2 * wlo + it) : (4 * whi + jt <= 2 * wlo + it);
            {
                const int j = tid >> 4, ec = (tid & 15) * 8;
#pragma unroll
                for (int x = 0; x < 4; ++x) {
                    const int jj = j + 32 * x;
                    const float z = __expf(lg * (float)(dir ? jj : 127 - jj));
                    u32x4 w; const u32x4 raw = rv[x];
                    w.x = cvt_pk_bf16(bflo(raw.x) * z, bfhi(raw.x) * z); w.y = cvt_pk_bf16(bflo(raw.y) * z, bfhi(raw.y) * z);
                    w.z = cvt_pk_bf16(bflo(raw.z) * z, bfhi(raw.z) * z); w.w = cvt_pk_bf16(bflo(raw.w) * z, bfhi(raw.w) * z);
                    *(LAS u32x4*)(VZ + jj * 272 + ec * 2) = w;
                }
            }
#pragma unroll
            for (int dh = 0; dh < 2; ++dh) {
                {
                    LAS unsigned char* lq = QH + (tid >> 4) * 272 + (tid & 15) * 16;
#pragma unroll
                    for (int x = 0; x < 4; ++x) { *(LAS u32x4*)(lq + x * 32 * 272) = rq[x]; *(LAS u32x4*)(lq + 34816 + x * 32 * 272) = rk[x]; }
                }
#pragma unroll
                for (int dt = 0; dt < 2; ++dt)
#pragma unroll
                    for (int et = 0; et < 4; ++et)
                        *(LAS u32x2*)(SH + ((4 * whi + et) * 16 + fr) * 272 + ((2 * wlo + dt) * 16 + 4 * fq) * 2) = pack4(accS[dh][dt][et]);
                __builtin_amdgcn_sched_barrier(0);
                if (dh == 0) { RET_LOADQK(row0, 1); } else if (step + 1 < 18) { RET_LOADV(row0n); RET_LOADQK(row0n, 0); }
                RET_BAR();
#pragma unroll
                for (int ks = 0; ks < 4; ++ks) {
                    bf16x8 qf[2], kf[4], sf[4];
#pragma unroll
                    for (int it = 0; it < 2; ++it) qf[it] = frag_row(QH, 272, (2 * wlo + it) * 16, ks * 32, lane);
#pragma unroll
                    for (int jt = 0; jt < 4; ++jt) kf[jt] = frag_row(KH, 272, (4 * whi + jt) * 16, ks * 32, lane);
#pragma unroll
                    for (int et = 0; et < 4; ++et) sf[et] = frag_row(SH, 272, (4 * whi + et) * 16, ks * 32, lane);
#pragma unroll
                    for (int jt = 0; jt < 4; ++jt)
#pragma unroll
                        for (int it = 0; it < 2; ++it) if (pv_ok[jt][it]) accP[jt][it] = mfma16(kf[jt], qf[it], accP[jt][it]);
#pragma unroll
                    for (int et = 0; et < 4; ++et)
#pragma unroll
                        for (int it = 0; it < 2; ++it) accO[et][it] = mfma16(sf[et], qf[it], accO[et][it]);
                    __builtin_amdgcn_sched_barrier(0);
                }
#pragma unroll
                for (int dt = 0; dt < 2; ++dt)
#pragma unroll
                    for (int et = 0; et < 4; ++et) accS[dh][dt][et] = accS[dh][dt][et] * gc;
#pragma unroll
                for (int ks = 0; ks < 4; ++ks) {
                    bf16x8 kt[2], vt[4];
#pragma unroll
                    for (int dt = 0; dt < 2; ++dt) kt[dt] = frag_tr(KH, 272, ks * 32, (2 * wlo + dt) * 16, lane);
#pragma unroll
                    for (int et = 0; et < 4; ++et) vt[et] = frag_tr(VZ, 272, ks * 32, (4 * whi + et) * 16, lane);
#pragma unroll
                    for (int dt = 0; dt < 2; ++dt)
#pragma unroll
                        for (int et = 0; et < 4; ++et) accS[dh][dt][et] = mfma16(kt[dt], vt[et], accS[dh][dt][et]);
                    __builtin_amdgcn_sched_barrier(0);
                }
                RET_BAR();
            }
#pragma unroll
            for (int it = 0; it < 2; ++it) {
                const int i = (2 * wlo + it) * 16 + fr;
                const float xi = __expf(lg * (float)(dir ? 128 - i : i + 1));
                const float mk = __expf(lg * (float)(dir ? -i : i - 127));
#pragma unroll
                for (int et = 0; et < 4; ++et) accO[et][it] = accO[et][it] * xi;
#pragma unroll
                for (int jt = 0; jt < 4; ++jt) {
                    const int j0 = (4 * whi + jt) * 16 + 4 * fq;
                    f32x4 pv; const int d0 = dir ? (j0 - i) : (i - j0), ds = dir ? 1 : -1;
#pragma unroll
                    for (int r = 0; r < 4; ++r) { const float mr = fminf(fmaxf((float)(d0 + r * ds + 1), 0.f), 1.f); pv[r] = accP[jt][it][r] * (mk * mr); }
                    *(LAS u32x2*)(QH + i * 272 + j0 * 2) = pack4(pv);
                }
            }
            RET_BAR();
#pragma unroll
            for (int ks = 0; ks < 4; ++ks) {
                bool need[2]; bool any = false;
#pragma unroll
                for (int it = 0; it < 2; ++it) { need[it] = dir ? (2 * ks + 1 >= 2 * wlo + it) : (2 * ks <= 2 * wlo + it); any = any || need[it]; }
                if (any) {
                    bf16x8 pf[2], vt[4];
#pragma unroll
                    for (int it = 0; it < 2; ++it) pf[it] = frag_row(QH, 272, (2 * wlo + it) * 16, ks * 32, lane);
#pragma unroll
                    for (int et = 0; et < 4; ++et) vt[et] = frag_tr(VZ, 272, ks * 32, (4 * whi + et) * 16, lane);
#pragma unroll
                    for (int et = 0; et < 4; ++et)
#pragma unroll
                        for (int it = 0; it < 2; ++it) if (need[it]) accO[et][it] = mfma16(vt[et], pf[it], accO[et][it]);
                }
                __builtin_amdgcn_sched_barrier(0);
            }
#pragma unroll
            for (int it = 0; it < 2; ++it) {
                const size_t row = row0 + (2 * wlo + it) * 16 + fr;
                float sm = 0.f, q2 = 0.f;
#pragma unroll
                for (int et = 0; et < 4; ++et) {
                    const f32x4 v = accO[et][it];
                    sm += (v[0] + v[1]) + (v[2] + v[3]); q2 += (v[0] * v[0] + v[1] * v[1]) + (v[2] * v[2] + v[3] * v[3]);
                    *(u32x2*)(O + row * 4096 + dir * 2048 + h * 512 + es * 128 + (4 * whi + et) * 16 + 4 * fq) = pack4(v);
                }
                sm += __shfl_xor(sm, 16); sm += __shfl_xor(sm, 32); q2 += __shfl_xor(q2, 16); q2 += __shfl_xor(q2, 32);
                if (fq == 0) *(f32x2*)(ST + ((row * 4 + h) * 2 + dir) * 16 + (es * 2 + whi) * 2) = (f32x2){sm, q2};
            }
            RET_BAR();
        }
#undef RET_CHUNK
#undef RET_LOADQK
#undef RET_LOADV
#undef RET_BAR
        {
            LAS unsigned* flag = (LAS unsigned*)(lds + 139264);
            asm volatile("s_waitcnt vmcnt(0)" ::: "memory");
            __syncthreads();
            if (threadIdx.x == 0) {
                __threadfence();
                const unsigned old = atomicAdd((unsigned*)(p.ws + WS_BAR) + CNT_WORD0 + (bl * 4 + h) * 2 + dir, 1u);
                flag[0] = ((old & 3u) == 3u) ? 1u : 0u;
            }
            __syncthreads();
            if (flag[0]) {
                __builtin_amdgcn_fence(__ATOMIC_ACQUIRE, "agent");
                float* FT = (float*)(p.ws + WS_FT);
                for (int r = threadIdx.x; r < RPB; r += NTHR) {
                    const size_t row = (size_t)bl * RPB + r;
                    const float* sp = ST + ((row * 4 + h) * 2 + dir) * 16;
                    const f32x4 p0 = *(const f32x4*)sp, p1 = *(const f32x4*)(sp + 4), p2 = *(const f32x4*)(sp + 8), p3 = *(const f32x4*)(sp + 12);
                    const float sm = (p0[0] + p0[2]) + (p1[0] + p1[2]) + (p2[0] + p2[2]) + (p3[0] + p3[2]);
                    const float sq = (p0[1] + p0[3]) + (p1[1] + p1[3]) + (p2[1] + p2[3]) + (p3[1] + p3[3]);
                    const float mu = sm * (1.f / 512.f), var = fmaxf(sq * (1.f / 512.f) - mu * mu, 0.f);
                    *(f32x2*)(FT + (row * 4 + h) * 4 + dir * 2) = (f32x2){mu, 1.0f / sqrtf(var + LN_EPS)};
                }
            }
            __syncthreads();
        }
    }
}

__device__ __forceinline__ void gemm_a_in(LAS unsigned char* lds, int jl) {
    const Params p = kparams(); unsigned char* ws = p.ws;
    EpiAct<1> E{(bf16_t*)(ws + WS_Z), 4096, p.a_b_in + jl * 4096};
    run_gemm(lds, (const bf16_t*)(ws + WS_H), 1024, (const bf16_t*)(ws + WS_WA_IN + jl * SZ_W4), 1024, MT / 256, 16, 0, 0, E);
}
__device__ __forceinline__ void gemm_out(LAS unsigned char* lds, size_t w_off, int K, int hb, int mode) {
    const Params p = kparams(); unsigned char* ws = p.ws;
    EpiAct<0> E{(bf16_t*)(ws + WS_H), 1024, nullptr};
    const bf16_t* Z = (const bf16_t*)(ws + WS_Z);
    const bf16_t* A = (mode == 1 || mode == 2) ? Z + (ptrdiff_t)HROWS * 4096 - (ptrdiff_t)hb * HROWS * 4096 : Z;
    const int nM = mode == 0 ? 288 : mode == 1 ? 144 : mode == 2 ? 128 : 256;
    run_gemm(lds, A, 4096, (const bf16_t*)(ws + w_off), K, nM, 4, (mode == 1 || mode == 2) ? hb * 144 : 0, mode >= 2 ? 1 : 0, E);
}
__device__ __forceinline__ void gemm_qkv(LAS unsigned char* lds, int jl, int hb) {
    const Params p = kparams(); unsigned char* ws = p.ws;
    const float* rc = (const float*)(ws + WS_ROPE);
    EpiQKV E{(bf16_t*)(ws + WS_Z) - (ptrdiff_t)hb * HROWS * 4096, rc, rc + 2048 * 128};
    run_gemm(lds, (const bf16_t*)(ws + WS_H), 1024, (const bf16_t*)(ws + WS_WB_QKV + jl * SZ_W4), 1024, 144, 16, hb * 144, 0, E);
}
__device__ __forceinline__ void gemm_gate(LAS unsigned char* lds, int jl, int hb, bool last) {
    const Params p = kparams(); unsigned char* ws = p.ws;
    EpiGate E{(bf16_t*)(ws + WS_Z) + (ptrdiff_t)HROWS * 4096 - (ptrdiff_t)hb * HROWS * 4096, (const float*)(ws + WS_FT) - (ptrdiff_t)hb * HROWS * 16};
    run_gemm(lds, (const bf16_t*)(ws + WS_H), 1024, (const bf16_t*)(ws + WS_WB_GATE + jl * SZ_W4), 1024, last ? 128 : 144, 16, hb * 144, last ? 1 : 0, E);
}
__device__ __forceinline__ void gemm_w1(LAS unsigned char* lds, int l, bool last) {
    const Params p = kparams(); unsigned char* ws = p.ws;
    EpiAct<2> E{(bf16_t*)(ws + WS_Z), 4096, nullptr};
    run_gemm(lds, (const bf16_t*)(ws + WS_H), 1024, (const bf16_t*)(ws + WS_W1 + l * SZ_W4), 1024, last ? 256 : 288, 16, 0, last ? 1 : 0, E);
}

#ifndef REP_SYNC
#define REP_SYNC 1
#endif
#ifndef REP_RET
#define REP_RET 1
#endif
#ifndef REP_GEMM
#define REP_GEMM 1
#endif
#ifndef REP_PRO
#define REP_PRO 1
#endif
#define GSYNC() do { for (int s_ = 0; s_ < REP_SYNC; ++s_) xcd_barrier(xbar); } while (0)
#define REPG(stmt) do { for (int r_ = 0; r_ < REP_GEMM; ++r_) { stmt; } } while (0)
__global__ void __launch_bounds__(NTHR, 2) fwd_kernel(Params pdummy) {
    extern __shared__ __attribute__((aligned(16))) unsigned char smem[];
    LAS unsigned char* lds = (LAS unsigned char*)smem;
    cg::grid_group grid = cg::this_grid();
    volatile LAS unsigned* bst = (volatile LAS unsigned*)(lds + LDS_BYTES - 16);
    unsigned* barw;
    { const Params p0 = kparams(); barw = (unsigned*)(p0.ws + WS_BAR);
      if (threadIdx.x < 4) bst[threadIdx.x] = 0u;
      if (blockIdx.x == 0) for (int i = threadIdx.x; i < 4096; i += NTHR) barw[i] = 0u; }
    for (int r_ = 0; r_ < REP_PRO; ++r_) prologue0(lds);
    grid.sync();
    const XcdBarrier xbar = xcd_barrier_post(barw, bst);
    for (int r_ = 0; r_ < REP_PRO; ++r_) prologue1();
    GSYNC();
#pragma unroll 1
    for (int l = 0; l < 4; ++l) {
        const int jl = l >> 1; const bool last = (l == 3);
        if ((l & 1) == 0) {
            REPG(gemm_a_in(lds, jl));
            GSYNC();
#ifdef PROBE_GATE
#pragma unroll 1
            for (int rep = 0; rep < 2; ++rep) { gating_phase(lds, jl, rep == 0); if (rep == 0) GSYNC(); }
#else
            gating_phase(lds, jl);
#endif
            GSYNC();
            REPG(gemm_out(lds, WS_WA_OUT + jl * (SZ_W4 / 2), 2048, 0, 0));
            GSYNC();
        } else {
#pragma unroll 1
            for (int hb = 0; hb < 2; ++hb) {
                REPG(gemm_qkv(lds, jl, hb));
                GSYNC();
                for (int r_ = 0; r_ < REP_RET; ++r_) retention_phase(lds, jl);
                GSYNC();
                gemm_gate(lds, jl, hb, last);
                GSYNC();
                REPG(gemm_out(lds, WS_WB_OUT + jl * (SZ_W4 / 2), 2048, hb, last ? 2 : 1));
                GSYNC();
            }
        }
#ifdef PROBE_LN
        ln_phase(l, 0, last, true); GSYNC();
#endif
        ln_phase(l, 0, last);
        GSYNC();
        REPG(gemm_w1(lds, l, last));
        GSYNC();
        REPG(gemm_out(lds, WS_W2 + l * SZ_W4, 4096, 0, last ? 3 : 0));
        GSYNC();
#ifdef PROBE_LN
        ln_phase(l, 1, last, true); GSYNC();
#endif
        ln_phase(l, 1, last);
        if (!last) GSYNC();
    }
}

extern "C" void kernel_launch(void* const* d_in, const int* in_sizes, int n_in, void* d_out, int out_size, void* d_ws, size_t ws_size, hipStream_t stream) {
    static int grid = 0;
    if (grid == 0) {
        if (n_in != 22 || ws_size < WS_END) { fprintf(stderr, "kernel_launch: need 22 inputs and %zu bytes of workspace (got %d, %zu)\n", (size_t)WS_END, n_in, ws_size); grid = -1; return; }
        int dev = 0, cus = 0, per_cu = 0;
        (void)hipGetDevice(&dev); (void)hipDeviceGetAttribute(&cus, hipDeviceAttributeMultiprocessorCount, dev);
        if (hipFuncSetAttribute((const void*)fwd_kernel, hipFuncAttributeMaxDynamicSharedMemorySize, LDS_BYTES) != hipSuccess) fprintf(stderr, "kernel_launch: hipFuncSetAttribute failed\n");
        if (hipOccupancyMaxActiveBlocksPerMultiprocessor(&per_cu, (const void*)fwd_kernel, NTHR, LDS_BYTES) != hipSuccess || per_cu < 1) fprintf(stderr, "kernel_launch: occupancy query says %d blocks per CU\n", per_cu);
        (void)hipGetLastError();
        grid = cus > 0 ? cus : 256;
    }
    if (grid < 0) return;
    Params p{};
    const float** pp = (const float**)&p;
    for (int i = 0; i < 22; ++i) pp[i] = (const float*)d_in[i];
    p.out = (float*)d_out; p.ws = (unsigned char*)d_ws;
    void* args[] = {&p};
    const hipError_t e = hipLaunchCooperativeKernel((const void*)fwd_kernel, dim3(grid), dim3(NTHR), args, LDS_BYTES, stream);
    if (e != hipSuccess) fprintf(stderr, "kernel_launch: cooperative launch failed: %s (grid %d)\n", hipGetErrorString(e), grid);
}
```
